# Optimizing an MI355X kernel written in HIP

```python
import jax, jax.numpy as jnp
from jax import lax
import numpy as np

D_MODEL = 2048
BATCH = 4
SEQ = 8192
DEPTH = 1
DEC_BATCH = 32
DEC_SEQ = 16
PAST_LEN = 2048

CHUNK = 64
SGU_CHUNK = 128
SGU_GROUPS = 8
D_SGU = D_MODEL
SGU_GROUP_DIM = D_SGU // SGU_GROUPS
SSM_EXPAND = 2
D_SSM = SSM_EXPAND * D_MODEL
SSM_HEADDIM = 64
SSM_HEADS = D_SSM // SSM_HEADDIM
SSM_GROUPS = 8
SSM_HPG = SSM_HEADS // SSM_GROUPS
SSM_STATE = 128
CONV_WIDTH = 4
CONV_DIM = D_SSM + 2 * SSM_GROUPS * SSM_STATE
SSM_BLOCK = CHUNK
N_BRANCH = 2
D_IN = 2 * D_SGU + D_SSM + CONV_DIM + SSM_HEADS + N_BRANCH * D_MODEL
D_FF = ((8 * D_MODEL // 3 + 255) // 256) * 256
EPS = 1e-6

kernel_name = "hybrid_sgu_ssd_streaming_step"


def _rmsnorm(x, g):
    xf = x.astype(jnp.float32)
    y = xf * lax.rsqrt(jnp.mean(xf * xf, axis=-1, keepdims=True) + EPS)
    return (y * g.astype(jnp.float32)).astype(x.dtype)


def _layernorm(x, g, b):
    xf = x.astype(jnp.float32)
    mu = jnp.mean(xf, axis=-1, keepdims=True)
    var = jnp.mean(jnp.square(xf - mu), axis=-1, keepdims=True)
    y = (xf - mu) * lax.rsqrt(var + EPS)
    return (y * g.astype(jnp.float32) + b.astype(jnp.float32)).astype(x.dtype)


def _sgu_mix(v, w_s, b_s):
    bsz, seq = v.shape[:2]
    q = min(seq, SGU_CHUNK)
    mask = jnp.tril(jnp.ones((q, q), dtype=w_s.dtype))
    w = w_s[:, :q, :q] * mask
    vc = v.reshape(bsz, seq // q, q, SGU_GROUPS, SGU_GROUP_DIM)
    out = jnp.einsum('gts,bcsgd->bctgd', w, vc) + b_s[:, :q].T[None, None, :, :, None]
    return out.reshape(bsz, seq, D_SGU)


def _causal_conv(xbc, buf, w, b):
    seq = xbc.shape[1]
    xpad = jnp.concatenate([buf.astype(xbc.dtype), xbc], axis=1)
    out = b
    for k in range(CONV_WIDTH):
        out = out + xpad[:, k:k + seq] * w[k]
    return out, xpad[:, seq:]


def _ssd(x, dt, a, bmat, cmat, h0, block):
    f32 = jnp.float32
    bsz, seq = x.shape[:2]
    nc = seq // block
    xdt = (x.astype(f32) * dt[..., None]).reshape(bsz, nc, block, SSM_GROUPS, SSM_HPG, SSM_HEADDIM)
    da = (dt * a).reshape(bsz, nc, block, SSM_GROUPS, SSM_HPG)
    bm = bmat.astype(f32).reshape(bsz, nc, block, SSM_GROUPS, SSM_STATE)
    cm = cmat.astype(f32).reshape(bsz, nc, block, SSM_GROUPS, SSM_STATE)
    xs_in = tuple(jnp.moveaxis(t, 1, 0) for t in (xdt, da, bm, cm))
    mask = jnp.tril(jnp.ones((block, block), dtype=bool))[None, :, :, None, None]

    def step(h, inp):
        xc, dac, bc, cc = inp
        cum = jnp.cumsum(dac, axis=1)
        seg = cum[:, :, None] - cum[:, None, :]
        decay = jnp.exp(jnp.where(mask, seg, -jnp.inf))
        cb = jnp.einsum('btgn,bsgn->btsg', cc, bc)
        y_in = jnp.einsum('btsg,btsgh,bsghp->btghp', cb, decay, xc)
        y_st = jnp.einsum('btgn,bghpn->btghp', cc, h) * jnp.exp(cum)[..., None]
        tail = jnp.exp(cum[:, -1:] - cum)
        h_new = h * jnp.exp(cum[:, -1])[..., None, None] + jnp.einsum('bsgn,bsgh,bsghp->bghpn', bc, tail, xc)
        return h_new, y_in + y_st

    h0r = h0.astype(f32).reshape(bsz, SSM_GROUPS, SSM_HPG, SSM_HEADDIM, SSM_STATE)
    h_t, ys = lax.scan(step, h0r, xs_in)
    ys = jnp.moveaxis(ys, 0, 1).reshape(bsz, seq, SSM_HEADS, SSM_HEADDIM)
    return ys, h_t.reshape(bsz, SSM_HEADS, SSM_HEADDIM, SSM_STATE)


def _mixer(h, ssm_h0, conv_buf, w_in, ln_g, ln_b, sgu_w, sgu_b, w_a, conv_w, conv_b,
           dt_bias, a_log, d_skip, ssm_norm_g, w_b, w_o):
    bsz, seq = h.shape[:2]
    proj = h @ w_in
    s0 = 2 * D_SGU
    s1 = s0 + D_SSM
    s2 = s1 + CONV_DIM
    s3 = s2 + SSM_HEADS
    uv, z, xbc, dt_raw, gates = jnp.split(proj, [s0, s1, s2, s3], axis=-1)
    uv = jax.nn.gelu(uv)
    u, v = jnp.split(uv, 2, axis=-1)
    v = _layernorm(v, ln_g, ln_b)
    y_a = (u * _sgu_mix(v, sgu_w, sgu_b)) @ w_a
    xbc, new_buf = _causal_conv(xbc, conv_buf, conv_w, conv_b)
    xbc = jax.nn.silu(xbc)
    xs, bmat, cmat = jnp.split(xbc, [D_SSM, D_SSM + SSM_GROUPS * SSM_STATE], axis=-1)
    xs = xs.reshape(bsz, seq, SSM_HEADS, SSM_HEADDIM)
    bmat = bmat.reshape(bsz, seq, SSM_GROUPS, SSM_STATE)
    cmat = cmat.reshape(bsz, seq, SSM_GROUPS, SSM_STATE)
    dt = jax.nn.softplus(dt_raw.astype(jnp.float32) + dt_bias.astype(jnp.float32))
    a = -jnp.exp(a_log.astype(jnp.float32))
    y_ssd, new_h = _ssd(xs, dt, a, bmat, cmat, ssm_h0, min(SSM_BLOCK, seq))
    y_ssd = y_ssd + d_skip.astype(jnp.float32)[:, None] * xs.astype(jnp.float32)
    y = y_ssd.reshape(bsz, seq, D_SSM).astype(h.dtype) * jax.nn.silu(z)
    y = _rmsnorm(y.reshape(bsz, seq, SSM_GROUPS, D_SSM // SSM_GROUPS),
                 ssm_norm_g.reshape(SSM_GROUPS, D_SSM // SSM_GROUPS)).reshape(bsz, seq, D_SSM)
    y_b = y @ w_b
    g_a, g_b = jnp.split(jax.nn.sigmoid(gates), 2, axis=-1)
    out = (g_a * y_a + g_b * y_b) @ w_o
    return out, new_h.astype(ssm_h0.dtype), new_buf, v


def _layer(x, ssm_h0, conv_buf, norm_mix_g, w_in, ln_g, ln_b, sgu_w, sgu_b, w_a, conv_w, conv_b,
           dt_bias, a_log, d_skip, ssm_norm_g, w_b, w_o, norm_ffn_g, w_gate, w_up, w_down):
    mix, new_h, new_buf, v = _mixer(_rmsnorm(x, norm_mix_g), ssm_h0, conv_buf, w_in, ln_g, ln_b,
                                    sgu_w, sgu_b, w_a, conv_w, conv_b, dt_bias, a_log, d_skip,
                                    ssm_norm_g, w_b, w_o)
    x = x + mix
    hf = _rmsnorm(x, norm_ffn_g)
    x = x + (jax.nn.silu(hf @ w_gate) * (hf @ w_up)) @ w_down
    return x, new_h, new_buf, v


def setup_inputs(seed: int = 0) -> dict:
    key = jax.random.key(seed)
    ks = jax.random.split(key, 24)
    f32 = jnp.float32
    nrm = lambda k, shape, scale: jax.random.normal(k, shape, f32) * scale
    dt0 = jnp.exp(jax.random.uniform(ks[10], (DEPTH, SSM_HEADS), f32, np.log(1e-3), np.log(1e-1)))
    return {
        "x_prompt": nrm(ks[0], (BATCH, SEQ, D_MODEL), 1.0),
        "x_sample": nrm(ks[1], (DEC_BATCH, DEC_SEQ, D_MODEL), 1.0),
        "state_ssm": nrm(ks[2], (DEPTH, DEC_BATCH, SSM_HEADS, SSM_HEADDIM, SSM_STATE), 0.1),
        "state_conv": nrm(ks[3], (DEPTH, DEC_BATCH, CONV_WIDTH - 1, CONV_DIM), 1.0),
        "norm_mix_g": 1.0 + nrm(ks[4], (DEPTH, D_MODEL), 0.02),
        "w_in": nrm(ks[5], (DEPTH, D_MODEL, D_IN), D_MODEL ** -0.5),
        "sgu_ln_g": 1.0 + nrm(ks[6], (DEPTH, D_SGU), 0.02),
        "sgu_ln_b": nrm(ks[7], (DEPTH, D_SGU), 0.02),
        "sgu_w": nrm(ks[8], (DEPTH, SGU_GROUPS, SGU_CHUNK, SGU_CHUNK), SGU_CHUNK ** -0.5),
        "sgu_b": 1.0 + nrm(ks[9], (DEPTH, SGU_GROUPS, SGU_CHUNK), 0.02),
        "w_a": nrm(ks[11], (DEPTH, D_SGU, D_MODEL), D_SGU ** -0.5),
        "conv_w": nrm(ks[12], (DEPTH, CONV_WIDTH, CONV_DIM), CONV_WIDTH ** -0.5),
        "conv_b": nrm(ks[13], (DEPTH, CONV_DIM), 0.02),
        "dt_bias": dt0 + jnp.log(-jnp.expm1(-dt0)),
        "a_log": jnp.log(jax.random.uniform(ks[14], (DEPTH, SSM_HEADS), f32, 1.0, 16.0)),
        "d_skip": 1.0 + nrm(ks[15], (DEPTH, SSM_HEADS), 0.02),
        "ssm_norm_g": 1.0 + nrm(ks[16], (DEPTH, D_SSM), 0.02),
        "w_b": nrm(ks[17], (DEPTH, D_SSM, D_MODEL), D_SSM ** -0.5),
        "w_o": nrm(ks[18], (DEPTH, D_MODEL, D_MODEL), D_MODEL ** -0.5),
        "norm_ffn_g": 1.0 + nrm(ks[19], (DEPTH, D_MODEL), 0.02),
        "w_gate": nrm(ks[20], (DEPTH, D_MODEL, D_FF), D_MODEL ** -0.5),
        "w_up": nrm(ks[21], (DEPTH, D_MODEL, D_FF), D_MODEL ** -0.5),
        "w_down": nrm(ks[22], (DEPTH, D_FF, D_MODEL), D_FF ** -0.5),
        "norm_final_g": 1.0 + nrm(ks[23], (D_MODEL,), 0.02),
    }


def reference(x_prompt, x_sample, state_ssm, state_conv, norm_mix_g, w_in, sgu_ln_g, sgu_ln_b,
              sgu_w, sgu_b, w_a, conv_w, conv_b, dt_bias, a_log, d_skip, ssm_norm_g, w_b, w_o,
              norm_ffn_g, w_gate, w_up, w_down, norm_final_g):
    params = (norm_mix_g, w_in, sgu_ln_g, sgu_ln_b, sgu_w, sgu_b, w_a, conv_w, conv_b, dt_bias,
              a_log, d_skip, ssm_norm_g, w_b, w_o, norm_ffn_g, w_gate, w_up, w_down)
    xp, xs = x_prompt, x_sample
    ssm_p, conv_p, ssm_s, conv_s, v_s = [], [], [], [], []
    for i in range(DEPTH):
        lp = [p[i] for p in params]
        h0_p = jnp.zeros((x_prompt.shape[0], SSM_HEADS, SSM_HEADDIM, SSM_STATE), x_prompt.dtype)
        buf_p = jnp.zeros((x_prompt.shape[0], CONV_WIDTH - 1, CONV_DIM), x_prompt.dtype)
        xp, hp, bp, _ = _layer(xp, h0_p, buf_p, *lp)
        xs, hs, bs, vs = _layer(xs, state_ssm[i], state_conv[i], *lp)
        ssm_p.append(hp)
        conv_p.append(bp)
        ssm_s.append(hs)
        conv_s.append(bs)
        v_s.append(vs)
    y_prompt = _rmsnorm(xp, norm_final_g)
    y_sample = _rmsnorm(xs, norm_final_g)
    new_ssm_prompt = jnp.stack(ssm_p)
    new_conv_prompt = jnp.stack(conv_p)
    new_ssm_sample = jnp.stack(ssm_s)
    new_conv_sample = jnp.stack(conv_s)
    new_sgu_v_sample = jnp.stack(v_s)
    return (y_prompt, y_sample, new_ssm_prompt, new_conv_prompt, new_ssm_sample, new_conv_sample, new_sgu_v_sample)
```

```cpp
#include <hip/hip_runtime.h>
#include <hip/hip_cooperative_groups.h>
#include <cstdio>
namespace cg = cooperative_groups;
namespace pg8 {
#define PG8_LAS __attribute__((address_space(3)))
typedef unsigned short bf16_t;
typedef short bf16x8 __attribute__((ext_vector_type(8)));
typedef float f32x4 __attribute__((ext_vector_type(4)));
typedef unsigned u32x4 __attribute__((ext_vector_type(4)));
constexpr int BM = 256, BK = 64, HALF = 128, HTB = HALF * BK * 2  , STAGE_BYTES = 8 * HTB, NXCD = 8, WGM = 8;

__host__ __device__ __forceinline__ int lds_byte(int r, int c) { const int st = (r >> 4) * 2 + (c >> 5), rr = r & 15, cc = c & 31, ob = rr * 64 + cc * 2; return st * 1024 + (ob ^ (((ob >> 9) & 1) << 5)); }
__host__ __device__ __forceinline__ void stage_rc(int b, int& R, int& C) { const int st = b / 1024, sb = b % 1024, swz = sb ^ (((sb >> 9) & 1) << 5); R = (st >> 1) * 16 + swz / 64; C = (st & 1) * 32 + (swz % 64) / 2; }
__host__ __device__ __forceinline__ int perm32(int rho) { const int n = rho >> 4, i = rho & 15; return 8 * (i >> 2) + 4 * n + (i & 3); }

struct Unit { int pm, pn; };
struct Gemm { const bf16_t* A; const bf16_t* Bt; int M, N, K; };

struct StaticOrder {
    int nM, nN, nwg, G, c;
    __host__ __device__ void init(int M, int N, int G_, int c_) { nM = M / BM; nN = N / BM; nwg = nM * nN; G = G_; c = c_; }
    __host__ __device__ bool next(int i, Unit& u) const {
        const long L = (long)i * G + c; if (L >= nwg) return false;
        int wgid = (int)L; { const int q = nwg / NXCD, r = nwg % NXCD, xcd = wgid % NXCD, off = wgid / NXCD; wgid = (xcd < r ? xcd * (q + 1) : r * (q + 1) + (xcd - r) * q) + off; }
        const int nig = WGM * nN, gid = wgid / nig, fm = gid * WGM, gsz = (nM - fm) < WGM ? (nM - fm) : WGM;
        u.pm = fm + ((wgid % nig) % gsz); u.pn = (wgid % nig) / gsz; return true;
    }
    __device__ __forceinline__ void a_ready(const Unit&) const {}
    __device__ __forceinline__ void done(const Unit&) const {}
};
__device__ __forceinline__ unsigned cvt_pk_bf16(float lo, float hi) { unsigned r; asm volatile("v_cvt_pk_bf16_f32 %0, %1, %2" : "=v"(r) : "v"(lo), "v"(hi)); return r; }
template <class Epi, class Sched, bool STAMP = false>
__device__ __forceinline__ void gemm_phase(PG8_LAS unsigned char* lds, const Gemm g, const Sched& S, const Epi& E, unsigned long long* stamps) {
    int tid_l = threadIdx.x; asm volatile("" : "+v"(tid_l));
    const int tid = tid_l, wid = __builtin_amdgcn_readfirstlane(tid >> 6), lane = tid & 63, wr = wid >> 2, wc = wid & 3, fr = lane & 15, fq = lane >> 4;
    const int K = g.K, nt = K / BK;
    int ts_lo = 0, ts_hi = 0, nts = 0; const unsigned long long rt_entry = STAMP ? (unsigned long long)wall_clock64() : 0ull;
#define PG8_STAMP() do { if (STAMP && wid == 0 && nts < 64) { const unsigned long long _c = (unsigned long long)clock64(); \
        ts_lo = (lane == nts) ? (int)(unsigned)_c : ts_lo; ts_hi = (lane == nts) ? (int)(unsigned)(_c >> 32) : ts_hi; ++nts; } } while (0)
    PG8_STAMP();
    unsigned voffA[2], voffB[2];
#pragma unroll
    for (int i = 0; i < 2; ++i) { int R, C; stage_rc(tid * 16 + i * 8192, R, C); const int Rb = Epi::PERM ? ((R & ~31) + perm32(R & 31)) : R;
        voffA[i] = (unsigned)(R * K + C) * 2u; voffB[i] = (unsigned)(Rb * K + C) * 2u; }
    const size_t kstep = (size_t)(BK * 2);
    const size_t hstep = (size_t)HALF * K * 2;
    const size_t tstep = 2 * hstep;
    const unsigned ldsw = (unsigned)wid * 1024u;
    const int aoff = lds_byte(wr * 64 + fr, fq * 8), boff = lds_byte(wc * 32 + fr, fq * 8);
#define PG8_SA(b, h) (((b) * 2 + (h)) * HTB)
#define PG8_SB(b, h) ((4 + (b) * 2 + (h)) * HTB)
#define PG8_STAGE(bufoff, gbase, voff) do { _Pragma("unroll") for (int _i = 0; _i < 2; ++_i) \
        __builtin_amdgcn_global_load_lds((const unsigned*)((const char*)(gbase) + (voff)[_i]), (PG8_LAS unsigned*)(lds + (bufoff) + ldsw + _i * 8192), 16, 0, 0); } while (0)
#define PG8_LDA(dst, b, h) do { _Pragma("unroll") for (int m = 0; m < 4; ++m) _Pragma("unroll") for (int k = 0; k < 2; ++k) dst[m][k] = *(const PG8_LAS bf16x8*)(lds + PG8_SA(b, h) + aoff + m * 2048 + k * 1024); } while (0)
#define PG8_LDB(dst, b, h) do { _Pragma("unroll") for (int n = 0; n < 2; ++n) _Pragma("unroll") for (int k = 0; k < 2; ++k) dst[n][k] = *(const PG8_LAS bf16x8*)(lds + PG8_SB(b, h) + boff + n * 2048 + k * 1024); } while (0)
#define PG8_MMA(ai, bj, At, Bt) do { __builtin_amdgcn_s_setprio(1); _Pragma("unroll") for (int m = 0; m < 4; ++m) _Pragma("unroll") for (int n = 0; n < 2; ++n) _Pragma("unroll") for (int k = 0; k < 2; ++k) \
        acc[ai][bj][m][n] = __builtin_amdgcn_mfma_f32_16x16x32_bf16(Bt[n][k], At[m][k], acc[ai][bj][m][n], 0, 0, 0); __builtin_amdgcn_s_setprio(0); } while (0)
#define PG8_WAIT_V(n) asm volatile("s_waitcnt vmcnt(" #n ")" ::: "memory")
#define PG8_WAIT_L(n) asm volatile("s_waitcnt lgkmcnt(" #n ")" ::: "memory")
#define PG8_BAR __builtin_amdgcn_s_barrier()
#define PG8_SCHED __builtin_amdgcn_sched_barrier(0)
    Unit cur, nxt; int ui = 0;
    if (!S.next(0, cur)) return;
    f32x4 acc[2][2][4][2];
#pragma unroll
    for (int a = 0; a < 2; ++a)
#pragma unroll
        for (int b = 0; b < 2; ++b)
#pragma unroll
            for (int m = 0; m < 4; ++m)
#pragma unroll
                for (int n = 0; n < 2; ++n) acc[a][b][m][n] = (f32x4){0.f, 0.f, 0.f, 0.f};
    bf16x8 At[4][2], B0[2][2], B1[2][2];
    const char* cA = (const char*)g.A + (size_t)cur.pm * tstep; const char* cB = (const char*)g.Bt + (size_t)cur.pn * tstep;
    S.a_ready(cur);
    PG8_STAGE(PG8_SB(0, 0), cB, voffB); PG8_STAGE(PG8_SA(0, 0), cA, voffA); PG8_STAGE(PG8_SB(0, 1), cB + hstep, voffB); PG8_STAGE(PG8_SA(0, 1), cA + hstep, voffA);
    if (wr == 1) PG8_BAR;
    PG8_WAIT_V(4); PG8_BAR;
    PG8_STAGE(PG8_SB(1, 0), cB + kstep, voffB); PG8_STAGE(PG8_SA(1, 0), cA + kstep, voffA); PG8_STAGE(PG8_SB(1, 1), cB + hstep + kstep, voffB);
    PG8_WAIT_V(6); PG8_BAR;
    PG8_STAMP();
    for (;;) {
        const bool has_next = S.next(ui + 1, nxt);
        const char* nA = has_next ? (const char*)g.A + (size_t)nxt.pm * tstep : cA; const char* nB = has_next ? (const char*)g.Bt + (size_t)nxt.pn * tstep : cB;
        for (int t = 0; t < nt; t += 2) {
            const bool last = (t == nt - 2);
            const char* a1 = cA + (size_t)(t + 1) * kstep;
            const char* a2 = last ? nA : cA + (size_t)(t + 2) * kstep; const char* b2 = last ? nB : cB + (size_t)(t + 2) * kstep;
            const char* a3 = a2 + kstep; const char* b3 = b2 + kstep;
            if (last && has_next) S.a_ready(nxt);
            PG8_LDB(B0, 0, 0); PG8_SCHED; PG8_LDA(At, 0, 0); PG8_STAGE(PG8_SA(1, 1), a1 + hstep, voffA);
            PG8_WAIT_L(8); PG8_BAR; PG8_WAIT_L(0); PG8_MMA(0, 0, At, B0); PG8_BAR; PG8_SCHED;
            PG8_LDB(B1, 0, 1); PG8_STAGE(PG8_SB(0, 0), b2, voffB);
            PG8_BAR; PG8_WAIT_L(0); PG8_MMA(0, 1, At, B1); PG8_BAR;
            PG8_LDA(At, 0, 1); PG8_STAGE(PG8_SA(0, 0), a2, voffA);
            PG8_BAR; PG8_WAIT_L(0); PG8_MMA(1, 0, At, B0); PG8_BAR; PG8_SCHED;
            PG8_STAGE(PG8_SB(0, 1), b2 + hstep, voffB);
            PG8_WAIT_V(6); PG8_BAR; PG8_MMA(1, 1, At, B1); PG8_BAR;
            PG8_LDB(B0, 1, 0); PG8_SCHED; PG8_LDA(At, 1, 0); PG8_STAGE(PG8_SA(0, 1), a2 + hstep, voffA);
            PG8_WAIT_L(8); PG8_BAR; PG8_WAIT_L(0); PG8_MMA(0, 0, At, B0); PG8_BAR; PG8_SCHED;
            PG8_LDB(B1, 1, 1); PG8_STAGE(PG8_SB(1, 0), b3, voffB);
            PG8_BAR; PG8_WAIT_L(0); PG8_MMA(0, 1, At, B1); PG8_BAR;
            PG8_LDA(At, 1, 1); PG8_STAGE(PG8_SA(1, 0), a3, voffA);
            PG8_BAR; PG8_WAIT_L(0); PG8_MMA(1, 0, At, B0); PG8_BAR; PG8_SCHED;
            PG8_STAGE(PG8_SB(1, 1), b3 + hstep, voffB);
            PG8_WAIT_V(6); PG8_BAR; PG8_MMA(1, 1, At, B1); PG8_BAR;
        }
        PG8_STAMP();
        if constexpr (!Epi::AFTER_DRAIN) { E(acc, cur, wr, wc, fr, fq); S.done(cur); }
        PG8_STAMP();
        if (!has_next) break;
#pragma unroll
        for (int a = 0; a < 2; ++a)
#pragma unroll
            for (int b = 0; b < 2; ++b)
#pragma unroll
                for (int m = 0; m < 4; ++m)
#pragma unroll
                    for (int n = 0; n < 2; ++n) acc[a][b][m][n] = (f32x4){0.f, 0.f, 0.f, 0.f};
        cur = nxt; cA = nA; cB = nB; ++ui;
    }
    PG8_WAIT_V(0);
    if (wr == 0) PG8_BAR;
    PG8_BAR;
    if constexpr (Epi::AFTER_DRAIN) { E.fused(acc, cur, wr, wc, fr, fq, lds, wid, lane); S.done(cur); }
    PG8_STAMP();
    if (STAMP && wid == 0) { stamps[lane] = lane < nts ? (((unsigned long long)(unsigned)ts_hi << 32) | (unsigned)ts_lo) : 0ull;
        if (lane == 62) stamps[62] = rt_entry; if (lane == 63) stamps[63] = (unsigned long long)wall_clock64(); }
#undef PG8_STAMP
#undef PG8_SA
#undef PG8_SB
#undef PG8_STAGE
#undef PG8_LDA
#undef PG8_LDB
#undef PG8_MMA
#undef PG8_WAIT_V
#undef PG8_WAIT_L
#undef PG8_BAR
#undef PG8_SCHED
}
}

using pg8::bf16_t; using pg8::bf16x8; using pg8::f32x4; using pg8::u32x4;
typedef unsigned u32x2 __attribute__((ext_vector_type(2)));
#define LAS __attribute__((address_space(3)))

constexpr int DM = 2048, DSSM = 4096, CONVD = 6144, NHEAD = 64, DFF = 5632, NIN_PAD = 18688;
constexpr float EPSN = 1e-6f;
constexpr size_t MiB = (size_t)1 << 20;
constexpr size_t WS_WIN = 0, WS_WA = 73 * MiB, WS_WB = 81 * MiB, WS_WO = 97 * MiB, WS_WUP = 105 * MiB, WS_WDN = 149 * MiB;
constexpr size_t WS_H = 171 * MiB, WS_U = 235 * MiB, WS_V = 299 * MiB, WS_Z = 363 * MiB, WS_XBC = 491 * MiB, WS_G = 683 * MiB, WS_Y = 811 * MiB, WS_DT = 939 * MiB, WS_TAIL = 943 * MiB, WS_END = 944 * MiB;
constexpr size_t WS_MG = WS_XBC, WS_ACT = WS_XBC;
constexpr size_t O_YP = 0, O_YS = 67108864, O_SSMP = 68157440, O_CONVP = 70254592, O_SSMS = 70328320, O_CONVS = 87105536, O_VS = 87695360;
constexpr int LDS_BYTES = 131072;

__device__ __forceinline__ float bflo(unsigned w) { return __uint_as_float(w << 16); }
__device__ __forceinline__ float bfhi(unsigned w) { return __uint_as_float(w & 0xffff0000u); }
__device__ __forceinline__ float bf2f(bf16_t b) { return __uint_as_float(((unsigned)b) << 16); }
__device__ __forceinline__ unsigned pk2(float lo, float hi) { return pg8::cvt_pk_bf16(lo, hi); }
__device__ __forceinline__ bf16_t f2bf(float f) { return (bf16_t)(pk2(f, 0.f) & 0xffffu); }
__device__ __forceinline__ float sigm(float a) { return __builtin_amdgcn_rcpf(1.0f + __expf(-a)); }
__device__ __forceinline__ float wave_sum(float v) {
#pragma unroll
    for (int o = 1; o < 64; o <<= 1) v += __shfl_xor(v, o);
    return v;
}
struct RowMap { int Ls, Lfull, toff;
    __device__ __forceinline__ size_t operator()(int r) const { return (size_t)(r >> Ls) * Lfull + toff + (r & ((1 << Ls) - 1)); } };

__device__ __forceinline__ float act_k(float x, int kind) {
    const float a = (kind == 0) ? 1.5957691216f * (x + 0.044715f * x * x * x) : x;
    const float s = sigm(a);
    return kind == 3 ? s : (kind == 2 ? x : x * s);
}
struct EpiInProj {
    static constexpr bool PERM = true, AFTER_DRAIN = false;
    bf16_t *U, *V, *Z, *XBC, *G; float* DT; const float* dt_bias;
    __device__ __forceinline__ void operator()(const f32x4 (&acc)[2][2][4][2], const pg8::Unit& u, int wr, int wc, int fr, int fq) const {
        const int pn = u.pn; const int row0 = u.pm * 256 + wr * 64 + fr;
        if (pn == 72) {
            if (wc < 2) {
                const int cl = wc * 32 + 8 * fq;
                const f32x4 b0 = *(const f32x4*)(dt_bias + cl), b1 = *(const f32x4*)(dt_bias + cl + 4);
#pragma unroll
                for (int ai = 0; ai < 2; ++ai)
#pragma unroll
                    for (int m = 0; m < 4; ++m) {
                        float* rp = DT + (size_t)(row0 + ai * 128 + m * 16) * 64 + cl;
                        f32x4 v0 = acc[ai][0][m][0] + b0, v1 = acc[ai][0][m][1] + b1;
#pragma unroll
                        for (int j = 0; j < 4; ++j) { v0[j] = fmaxf(v0[j], 0.f) + log1pf(__expf(-fabsf(v0[j]))); v1[j] = fmaxf(v1[j], 0.f) + log1pf(__expf(-fabsf(v1[j]))); }
                        *(f32x4*)rp = v0; *(f32x4*)(rp + 4) = v1;
                    }
            }
            return;
        }
        int kind, ldc, colt; bf16_t* base;
        if (pn < 8) { kind = 0; base = U; ldc = 2048; colt = pn * 256; }
        else if (pn < 16) { kind = 0; base = V; ldc = 2048; colt = (pn - 8) * 256; }
        else if (pn < 32) { kind = 1; base = Z; ldc = 4096; colt = (pn - 16) * 256; }
        else if (pn < 56) { kind = 2; base = XBC; ldc = 6144; colt = (pn - 32) * 256; }
        else { kind = 3; base = G; ldc = 4096; colt = (pn - 56) * 256; }
        const int col0 = colt + wc * 32 + 8 * fq;
#pragma unroll
        for (int ai = 0; ai < 2; ++ai)
#pragma unroll
            for (int m = 0; m < 4; ++m) {
                bf16_t* rowp = base + (size_t)(row0 + ai * 128 + m * 16) * ldc + col0;
#pragma unroll
                for (int bj = 0; bj < 2; ++bj) {
                    const f32x4 v0 = acc[ai][bj][m][0], v1 = acc[ai][bj][m][1];
                    u32x4 w;
                    w.x = pk2(act_k(v0[0], kind), act_k(v0[1], kind)); w.y = pk2(act_k(v0[2], kind), act_k(v0[3], kind));
                    w.z = pk2(act_k(v1[0], kind), act_k(v1[1], kind)); w.w = pk2(act_k(v1[2], kind), act_k(v1[3], kind));
                    *(u32x4*)(rowp + bj * 128) = w;
                }
            }
    }
};
template <bool ACCUM> struct EpiGate {
    static constexpr bool PERM = true, AFTER_DRAIN = false;
    bf16_t* MG; const bf16_t* Gt; int goff;
    __device__ __forceinline__ void operator()(const f32x4 (&acc)[2][2][4][2], const pg8::Unit& u, int wr, int wc, int fr, int fq) const {
        const int row0 = u.pm * 256 + wr * 64 + fr, col0 = u.pn * 256 + wc * 32 + 8 * fq;
#pragma unroll
        for (int ai = 0; ai < 2; ++ai)
#pragma unroll
            for (int m = 0; m < 4; ++m) {
                const size_t r = (size_t)(row0 + ai * 128 + m * 16);
#pragma unroll
                for (int bj = 0; bj < 2; ++bj) {
                    const int c = col0 + bj * 128;
                    const u32x4 gw = *(const u32x4*)(Gt + r * 4096 + goff + c);
                    const f32x4 v0 = acc[ai][bj][m][0], v1 = acc[ai][bj][m][1];
                    float o0 = bflo(gw.x) * v0[0], o1 = bfhi(gw.x) * v0[1], o2 = bflo(gw.y) * v0[2], o3 = bfhi(gw.y) * v0[3];
                    float o4 = bflo(gw.z) * v1[0], o5 = bfhi(gw.z) * v1[1], o6 = bflo(gw.w) * v1[2], o7 = bfhi(gw.w) * v1[3];
                    bf16_t* dst = MG + r * 2048 + c;
                    if (ACCUM) { const u32x4 pw = *(const u32x4*)dst;
                        o0 += bflo(pw.x); o1 += bfhi(pw.x); o2 += bflo(pw.y); o3 += bfhi(pw.y); o4 += bflo(pw.z); o5 += bfhi(pw.z); o6 += bflo(pw.w); o7 += bfhi(pw.w); }
                    u32x4 w; w.x = pk2(o0, o1); w.y = pk2(o2, o3); w.z = pk2(o4, o5); w.w = pk2(o6, o7);
                    *(u32x4*)dst = w;
                }
            }
    }
};
struct EpiSwiGLU {
    static constexpr bool PERM = true, AFTER_DRAIN = false;
    bf16_t* ACT;
    __device__ __forceinline__ void operator()(const f32x4 (&acc)[2][2][4][2], const pg8::Unit& u, int wr, int wc, int fr, int fq) const {
        const int row0 = u.pm * 256 + wr * 64 + fr, j0 = u.pn * 128 + wc * 16 + 4 * fq;
#pragma unroll
        for (int ai = 0; ai < 2; ++ai)
#pragma unroll
            for (int m = 0; m < 4; ++m) {
                bf16_t* rowp = ACT + (size_t)(row0 + ai * 128 + m * 16) * DFF + j0;
#pragma unroll
                for (int bj = 0; bj < 2; ++bj) {
                    const f32x4 g = acc[ai][bj][m][0], up = acc[ai][bj][m][1];
                    u32x2 w; w.x = pk2(g[0] * sigm(g[0]) * up[0], g[1] * sigm(g[1]) * up[1]); w.y = pk2(g[2] * sigm(g[2]) * up[2], g[3] * sigm(g[3]) * up[3]);
                    *(u32x2*)(rowp + bj * 64) = w;
                }
            }
    }
};
struct EpiResid {
    static constexpr bool PERM = false, AFTER_DRAIN = false;
    const float* base; float* out; RowMap rm;
    __device__ __forceinline__ void operator()(const f32x4 (&acc)[2][2][4][2], const pg8::Unit& u, int wr, int wc, int fr, int fq) const {
        const int row0 = u.pm * 256 + wr * 64 + fr, col0 = u.pn * 256 + wc * 32 + 4 * fq;
#pragma unroll
        for (int ai = 0; ai < 2; ++ai)
#pragma unroll
            for (int m = 0; m < 4; ++m) {
                const size_t off = rm(row0 + ai * 128 + m * 16) * 2048 + col0;
#pragma unroll
                for (int bj = 0; bj < 2; ++bj)
#pragma unroll
                    for (int n = 0; n < 2; ++n) {
                        const f32x4 b = *(const f32x4*)(base + off + bj * 128 + n * 16);
                        *(f32x4*)(out + off + bj * 128 + n * 16) = b + acc[ai][bj][m][n];
                    }
            }
    }
};

__device__ __forceinline__ void rmsnorm_rows_bf16(const float* src, RowMap rm, const float* g, bf16_t* dst, int R, int gw, int NGW, int lane) {
    asm volatile("" : "+v"(lane)); asm volatile("" : "+s"(gw));
    for (int r = gw; r < R; r += NGW) {
        const f32x4* xr = (const f32x4*)(src + rm(r) * 2048) + lane;
        f32x4 v[8]; float ss = 0.f;
#pragma unroll
        for (int j = 0; j < 8; ++j) { v[j] = xr[64 * j]; ss += (v[j].x * v[j].x + v[j].y * v[j].y) + (v[j].z * v[j].z + v[j].w * v[j].w); }
        const float rstd = rsqrtf(wave_sum(ss) * (1.f / 2048.f) + EPSN);
        u32x2* o = (u32x2*)(dst + (size_t)r * 2048) + lane;
#pragma unroll
        for (int j = 0; j < 8; ++j) { const f32x4 gg = ((const f32x4*)g)[lane + 64 * j];
            u32x2 w; w.x = pk2(v[j].x * rstd * gg.x, v[j].y * rstd * gg.y); w.y = pk2(v[j].z * rstd * gg.z, v[j].w * rstd * gg.w); o[64 * j] = w; }
    }
}
__device__ __forceinline__ void rmsnorm_rows_inplace(float* buf, RowMap rm, const float* g, int R, int gw, int NGW, int lane) {
    asm volatile("" : "+v"(lane)); asm volatile("" : "+s"(gw));
    for (int r = gw; r < R; r += NGW) {
        f32x4* xr = (f32x4*)(buf + rm(r) * 2048) + lane;
        f32x4 v[8]; float ss = 0.f;
#pragma unroll
        for (int j = 0; j < 8; ++j) { v[j] = xr[64 * j]; ss += (v[j].x * v[j].x + v[j].y * v[j].y) + (v[j].z * v[j].z + v[j].w * v[j].w); }
        const float rstd = rsqrtf(wave_sum(ss) * (1.f / 2048.f) + EPSN);
#pragma unroll
        for (int j = 0; j < 8; ++j) { const f32x4 gg = ((const f32x4*)g)[lane + 64 * j]; xr[64 * j] = v[j] * rstd * gg; }
    }
}
__device__ __forceinline__ void ln_rows(bf16_t* V, const float* lg, const float* lb, float* vout, int R, int gw, int NGW, int lane) {
    asm volatile("" : "+v"(lane)); asm volatile("" : "+s"(gw));
    for (int r = gw; r < R; r += NGW) {
        u32x4* vr = (u32x4*)(V + (size_t)r * 2048) + lane;
        float x[4][8]; float s = 0.f;
#pragma unroll
        for (int j = 0; j < 4; ++j) { const u32x4 w = vr[64 * j];
            x[j][0] = bflo(w.x); x[j][1] = bfhi(w.x); x[j][2] = bflo(w.y); x[j][3] = bfhi(w.y); x[j][4] = bflo(w.z); x[j][5] = bfhi(w.z); x[j][6] = bflo(w.w); x[j][7] = bfhi(w.w);
#pragma unroll
            for (int k = 0; k < 8; ++k) s += x[j][k]; }
        const float mu = wave_sum(s) * (1.f / 2048.f); float q = 0.f;
#pragma unroll
        for (int j = 0; j < 4; ++j)
#pragma unroll
            for (int k = 0; k < 8; ++k) { x[j][k] -= mu; q += x[j][k] * x[j][k]; }
        const float rstd = rsqrtf(wave_sum(q) * (1.f / 2048.f) + EPSN);
#pragma unroll
        for (int j = 0; j < 4; ++j) { const int c = (lane + 64 * j) * 8;
            const f32x4 g0 = *(const f32x4*)(lg + c), g1 = *(const f32x4*)(lg + c + 4), b0 = *(const f32x4*)(lb + c), b1 = *(const f32x4*)(lb + c + 4);
            f32x4 y0, y1;
            y0.x = x[j][0] * rstd * g0.x + b0.x; y0.y = x[j][1] * rstd * g0.y + b0.y; y0.z = x[j][2] * rstd * g0.z + b0.z; y0.w = x[j][3] * rstd * g0.w + b0.w;
            y1.x = x[j][4] * rstd * g1.x + b1.x; y1.y = x[j][5] * rstd * g1.y + b1.y; y1.z = x[j][6] * rstd * g1.z + b1.z; y1.w = x[j][7] * rstd * g1.w + b1.w;
            u32x4 w; w.x = pk2(y0.x, y0.y); w.y = pk2(y0.z, y0.w); w.z = pk2(y1.x, y1.y); w.w = pk2(y1.z, y1.w); vr[64 * j] = w;
            if (vout) { float* o = vout + (size_t)r * 2048 + c; *(f32x4*)o = y0; *(f32x4*)(o + 4) = y1; } }
    }
}
__device__ __forceinline__ void gnorm_rows(bf16_t* Y, int R, int gw, int NGW, int lane) {
    asm volatile("" : "+v"(lane)); asm volatile("" : "+s"(gw));
    for (int r = gw; r < R; r += NGW) {
        u32x4* yr = (u32x4*)(Y + (size_t)r * 4096) + lane;
#pragma unroll
        for (int j = 0; j < 8; ++j) { const u32x4 w = yr[64 * j];
            float x0 = bflo(w.x), x1 = bfhi(w.x), x2 = bflo(w.y), x3 = bfhi(w.y), x4 = bflo(w.z), x5 = bfhi(w.z), x6 = bflo(w.w), x7 = bfhi(w.w);
            const float ss = (x0 * x0 + x1 * x1) + (x2 * x2 + x3 * x3) + (x4 * x4 + x5 * x5) + (x6 * x6 + x7 * x7);
            const float rstd = rsqrtf(wave_sum(ss) * (1.f / 512.f) + EPSN);
            u32x4 o; o.x = pk2(x0 * rstd, x1 * rstd); o.y = pk2(x2 * rstd, x3 * rstd); o.z = pk2(x4 * rstd, x5 * rstd); o.w = pk2(x6 * rstd, x7 * rstd); yr[64 * j] = o; }
    }
}

__device__ __forceinline__ int wt_rowmap(int mode, int n) {
    if (mode == 1) return n < 14336 ? n : (n < 14400 ? 18432 + (n - 14336) : n - 64);
    if (mode == 2) return 8 * (n >> 2) + (n & 3);
    if (mode == 3) return 8 * (n >> 2) + 4 + (n & 3);
    return n;
}
__device__ __forceinline__ void transpose_item(const float* W, int K, int N, bf16_t* WT, LAS float* scr, int item, int lane, int mode, const float* kscale) {
    const int nblk = N / 32, kb = item / nblk, nb = item % nblk, k0 = 64 * kb, n0 = 32 * nb;
#pragma unroll 8
    for (int i = 0; i < 32; ++i) { const int kk = 2 * i + (lane >> 5); float v = W[(size_t)(k0 + kk) * N + n0 + (lane & 31)]; if (kscale) v *= kscale[k0 + kk]; scr[kk * 33 + (lane & 31)] = v; }
    asm volatile("s_waitcnt lgkmcnt(0)" ::: "memory");
    const int c = lane & 7;
#pragma unroll
    for (int j = 0; j < 4; ++j) { const int n = (lane >> 3) + 8 * j; const LAS float* s = scr + (8 * c) * 33 + n;
        u32x4 o; o.x = pk2(s[0 * 33], s[1 * 33]); o.y = pk2(s[2 * 33], s[3 * 33]); o.z = pk2(s[4 * 33], s[5 * 33]); o.w = pk2(s[6 * 33], s[7 * 33]);
        *(u32x4*)(WT + (size_t)wt_rowmap(mode, n0 + n) * K + k0 + 8 * c) = o; }
    asm volatile("s_waitcnt lgkmcnt(0)" ::: "memory");
}

__device__ __forceinline__ void sgu_phase(LAS unsigned char* lds, const bf16_t* U, const bf16_t* VN, bf16_t* SA, const float* sgu_w, const float* sgu_b, int nchunks, int q, int G) {
    int tid_l = threadIdx.x; asm volatile("" : "+v"(tid_l));
    const int tid = tid_l, wave = __builtin_amdgcn_readfirstlane(tid >> 6), lane = tid & 63, l15 = lane & 15, quad = lane >> 4;
    LAS bf16_t* Wl = (LAS bf16_t*)lds;
    LAS bf16_t* Vl = (LAS bf16_t*)(lds + 128 * 136 * 2);
    const int nmt = q >> 4, nks = (q + 31) >> 5;
    for (int unit = blockIdx.x; unit < nchunks * 8; unit += G) {
        const int chunk = unit >> 3, g = unit & 7, c0 = chunk * q;
#pragma unroll
        for (int i = 0; i < 8; ++i) { const int ch = tid + 512 * i, t = ch >> 5, s4 = (ch & 31) * 4;
            const f32x4 w = *(const f32x4*)(sgu_w + ((size_t)(g * 128 + t) * 128 + s4));
            const bool tv = t < q;
            u32x2 o; o.x = pk2((tv && s4 <= t) ? w.x : 0.f, (tv && s4 + 1 <= t) ? w.y : 0.f); o.y = pk2((tv && s4 + 2 <= t) ? w.z : 0.f, (tv && s4 + 3 <= t) ? w.w : 0.f);
            *(LAS u32x2*)(Wl + t * 136 + s4) = o; }
#pragma unroll
        for (int i = 0; i < 8; ++i) { const int ch = tid + 512 * i, s = ch >> 5, c8 = (ch & 31) * 8;
            u32x4 v = (u32x4){0u, 0u, 0u, 0u};
            if (s < q) v = *(const u32x4*)(VN + (size_t)(c0 + s) * 2048 + g * 256 + c8);
            LAS unsigned* d = (LAS unsigned*)(Vl + s * 258 + c8); d[0] = v.x; d[1] = v.y; d[2] = v.z; d[3] = v.w; }
        __syncthreads();
        f32x4 acc[8][2];
#pragma unroll
        for (int mt = 0; mt < 8; ++mt) { acc[mt][0] = (f32x4){0.f, 0.f, 0.f, 0.f}; acc[mt][1] = (f32x4){0.f, 0.f, 0.f, 0.f}; }
#pragma unroll
        for (int ks = 0; ks < 4; ++ks) {
            if (ks < nks) {
                bf16x8 bfr[2];
#pragma unroll
                for (int nt = 0; nt < 2; ++nt) { const int d = 32 * wave + 16 * nt + l15;
#pragma unroll
                    for (int i = 0; i < 8; ++i) bfr[nt][i] = (short)Vl[(32 * ks + 8 * quad + i) * 258 + d]; }
#pragma unroll
                for (int mt = 0; mt < 8; ++mt) {
                    if (mt < nmt && 16 * mt + 15 >= 32 * ks) {
                        const bf16x8 afr = *(const LAS bf16x8*)(Wl + (16 * mt + l15) * 136 + 32 * ks + 8 * quad);
                        acc[mt][0] = __builtin_amdgcn_mfma_f32_16x16x32_bf16(bfr[0], afr, acc[mt][0], 0, 0, 0);
                        acc[mt][1] = __builtin_amdgcn_mfma_f32_16x16x32_bf16(bfr[1], afr, acc[mt][1], 0, 0, 0);
                    }
                }
            }
        }
#pragma unroll
        for (int mt = 0; mt < 8; ++mt) {
            if (mt < nmt) {
                const int t = 16 * mt + l15; const size_t row = (size_t)(c0 + t); const float bias = sgu_b[g * 128 + t];
#pragma unroll
                for (int nt = 0; nt < 2; ++nt) { const int d0 = g * 256 + 32 * wave + 16 * nt + 4 * quad;
                    const u32x2 uw = *(const u32x2*)(U + row * 2048 + d0);
                    u32x2 o; o.x = pk2(bflo(uw.x) * (acc[mt][nt][0] + bias), bfhi(uw.x) * (acc[mt][nt][1] + bias)); o.y = pk2(bflo(uw.y) * (acc[mt][nt][2] + bias), bfhi(uw.y) * (acc[mt][nt][3] + bias));
                    *(u32x2*)(SA + row * 2048 + d0) = o; }
            }
        }
        __syncthreads();
    }
}

__device__ __forceinline__ void ssd_phase(LAS unsigned char* lds, const bf16_t* XBC, const float* DT, const bf16_t* Zs, bf16_t* Y,
                                          const float* hist, const float* h0, float* hout, const float* conv_w, const float* conv_b, const float* a_log, const float* d_skip,
                                          int nb, int L, int G) {
    int tid_l = threadIdx.x; asm volatile("" : "+v"(tid_l));
    const int tid = tid_l, wave = __builtin_amdgcn_readfirstlane(tid >> 6), lane = tid & 63, l15 = lane & 15, quad = lane >> 4;
    LAS float* xs_nat = (LAS float*)(lds);
    LAS bf16_t* xdtT = (LAS bf16_t*)(lds + 17408);
    LAS bf16_t* Bnat = (LAS bf16_t*)(lds + 26624);
    LAS bf16_t* BtT = (LAS bf16_t*)(lds + 44032);
    LAS bf16_t* Cnat = (LAS bf16_t*)(lds + 62464);
    LAS bf16_t* Ml = (LAS bf16_t*)(lds + 79872);
    LAS bf16_t* Hl = (LAS bf16_t*)(lds + 89088);
    LAS float* scal = (LAS float*)(lds + 106496);
    const int nchunks = (L + 63) >> 6;
    const bool loader = tid < 320; const int run = tid / 80, qi = tid % 80;
    const int kind = qi < 16 ? 0 : (qi < 48 ? 1 : 2);
    const int lc = kind == 0 ? 4 * qi : (kind == 1 ? 4 * (qi - 16) : 4 * (qi - 48));
    const int tt = wave >> 1, wlo = wave & 1;
    int stepctr = 0;
    for (int unit = blockIdx.x; unit < nb * 64; unit += G) {
        const int b = unit >> 6, h = unit & 63, g = h >> 3;
        const float aneg = -__expf(a_log[h]), Dh = d_skip[h];
        const int col = kind == 0 ? h * 64 + lc : (kind == 1 ? 4096 + g * 128 + lc : 5120 + g * 128 + lc);
        f32x4 cw[4], cb;
        if (loader) { cb = *(const f32x4*)(conv_b + col);
#pragma unroll
            for (int k = 0; k < 4; ++k) cw[k] = *(const f32x4*)(conv_w + k * CONVD + col); }
        else { cb = (f32x4){0.f, 0.f, 0.f, 0.f};
#pragma unroll
            for (int k = 0; k < 4; ++k) cw[k] = (f32x4){0.f, 0.f, 0.f, 0.f}; }
        f32x4 hacc[4];
#pragma unroll
        for (int i = 0; i < 4; ++i) {
            if (h0) {
#pragma unroll
                for (int jj = 0; jj < 4; ++jj) hacc[i][jj] = h0[((size_t)(b * 64 + h) * 64 + 16 * tt + 4 * quad + jj) * 128 + 16 * (wlo * 4 + i) + l15];
            } else hacc[i] = (f32x4){0.f, 0.f, 0.f, 0.f};
        }
        u32x2 raw[19];
#define SSD_LOAD_RAW(cc) do { if (loader) { _Pragma("unroll") for (int i = 0; i < 19; ++i) { const int tl = (cc) * 64 + 16 * run - 3 + i; u32x2 v = (u32x2){0u, 0u}; \
            if (tl < 0) { if (hist) { const f32x4 f = *(const f32x4*)(hist + (size_t)(b * 3 + 3 + tl) * CONVD + col); v.x = pk2(f.x, f.y); v.y = pk2(f.z, f.w); } } \
            else if (tl < L) v = *(const u32x2*)(XBC + (size_t)(b * L + tl) * CONVD + col); \
            raw[i] = v; } } } while (0)
        SSD_LOAD_RAW(0);
        float dtn = 0.f;
        if (wave == 5) dtn = (lane < L) ? DT[(size_t)(b * L + lane) * 64 + h] : 0.f;
        for (int c = 0; c < nchunks; ++c) {
            LAS float* sc = scal + (stepctr & 1) * 320;
            if (wave == 5) {
                const float dtv = dtn; float cum = dtv * aneg;
#pragma unroll
                for (int o = 1; o < 64; o <<= 1) { const float v = __shfl_up(cum, o); if (lane >= o) cum += v; }
                const float cumL = __shfl(cum, 63);
                sc[lane] = dtv; sc[64 + lane] = cum; sc[128 + lane] = __expf(cum); sc[192 + lane] = __expf(cumL - cum);
                if (lane == 0) sc[256] = __expf(cumL);
            }
            __syncthreads();
            if (loader) {
#pragma unroll
                for (int i = 0; i < 16; i += 2) {
                    float sv[2][4];
#pragma unroll
                    for (int e = 0; e < 2; ++e) {
                        const int ii = i + e; const bool valid = (c * 64 + 16 * run + ii) < L;
                        float v0 = cb.x, v1 = cb.y, v2 = cb.z, v3 = cb.w;
#pragma unroll
                        for (int k = 0; k < 4; ++k) { const u32x2 rw = raw[ii + k];
                            v0 += bflo(rw.x) * cw[k].x; v1 += bfhi(rw.x) * cw[k].y; v2 += bflo(rw.y) * cw[k].z; v3 += bfhi(rw.y) * cw[k].w; }
                        sv[e][0] = valid ? v0 * sigm(v0) : 0.f; sv[e][1] = valid ? v1 * sigm(v1) : 0.f; sv[e][2] = valid ? v2 * sigm(v2) : 0.f; sv[e][3] = valid ? v3 * sigm(v3) : 0.f;
                    }
                    const int t = 16 * run + i;
                    if (kind == 0) {
                        *(LAS f32x4*)(xs_nat + t * 68 + lc) = (f32x4){sv[0][0], sv[0][1], sv[0][2], sv[0][3]};
                        *(LAS f32x4*)(xs_nat + (t + 1) * 68 + lc) = (f32x4){sv[1][0], sv[1][1], sv[1][2], sv[1][3]};
                        const float d0 = sc[t], d1 = sc[t + 1];
#pragma unroll
                        for (int k = 0; k < 4; ++k) *(LAS unsigned*)(xdtT + (lc + k) * 72 + t) = pk2(sv[0][k] * d0, sv[1][k] * d1);
                    } else if (kind == 1) {
                        u32x2 o0; o0.x = pk2(sv[0][0], sv[0][1]); o0.y = pk2(sv[0][2], sv[0][3]); *(LAS u32x2*)(Bnat + t * 136 + lc) = o0;
                        u32x2 o1; o1.x = pk2(sv[1][0], sv[1][1]); o1.y = pk2(sv[1][2], sv[1][3]); *(LAS u32x2*)(Bnat + (t + 1) * 136 + lc) = o1;
                        const float d0 = sc[192 + t], d1 = sc[192 + t + 1];
#pragma unroll
                        for (int k = 0; k < 4; ++k) *(LAS unsigned*)(BtT + (lc + k) * 72 + t) = pk2(sv[0][k] * d0, sv[1][k] * d1);
                    } else {
                        u32x2 o0; o0.x = pk2(sv[0][0], sv[0][1]); o0.y = pk2(sv[0][2], sv[0][3]); *(LAS u32x2*)(Cnat + t * 136 + lc) = o0;
                        u32x2 o1; o1.x = pk2(sv[1][0], sv[1][1]); o1.y = pk2(sv[1][2], sv[1][3]); *(LAS u32x2*)(Cnat + (t + 1) * 136 + lc) = o1;
                    }
                }
            }
            if (c + 1 < nchunks) { SSD_LOAD_RAW(c + 1); if (wave == 5) { const int tl = (c + 1) * 64 + lane; dtn = (tl < L) ? DT[(size_t)(b * L + tl) * 64 + h] : 0.f; } }
            bf16_t zr[2][4];
#pragma unroll
            for (int pi = 0; pi < 2; ++pi)
#pragma unroll
                for (int jj = 0; jj < 4; ++jj) { const int tl = c * 64 + 16 * tt + 4 * quad + jj;
                    zr[pi][jj] = (tl < L) ? Zs[(size_t)(b * L + tl) * DSSM + h * 64 + 16 * (wlo * 2 + pi) + l15] : (bf16_t)0; }
            __syncthreads();
            bf16x8 Cfr[4];
#pragma unroll
            for (int kn = 0; kn < 4; ++kn) Cfr[kn] = *(const LAS bf16x8*)(Cnat + (16 * tt + l15) * 136 + 32 * kn + 8 * quad);
#pragma unroll
            for (int si = 0; si < 2; ++si) { const int st = wlo * 2 + si;
                f32x4 acc = (f32x4){0.f, 0.f, 0.f, 0.f};
#pragma unroll
                for (int kn = 0; kn < 4; ++kn) { const bf16x8 bfr = *(const LAS bf16x8*)(Bnat + (16 * st + l15) * 136 + 32 * kn + 8 * quad);
                    acc = __builtin_amdgcn_mfma_f32_16x16x32_bf16(Cfr[kn], bfr, acc, 0, 0, 0); }
                const int s = 16 * st + l15; const float cs = sc[64 + s];
#pragma unroll
                for (int jj = 0; jj < 4; ++jj) { const int t = 16 * tt + 4 * quad + jj; const float ct = sc[64 + t];
                    const float m = (s <= t) ? acc[jj] * __expf(ct - cs) : 0.f; Ml[t * 72 + s] = f2bf(m); }
            }
#pragma unroll
            for (int i = 0; i < 4; ++i)
#pragma unroll
                for (int jj = 0; jj < 4; ++jj) Hl[(16 * tt + 4 * quad + jj) * 136 + 16 * (wlo * 4 + i) + l15] = f2bf(hacc[i][jj]);
            __syncthreads();
#pragma unroll
            for (int pi = 0; pi < 2; ++pi) { const int pp = wlo * 2 + pi;
                f32x4 acc = (f32x4){0.f, 0.f, 0.f, 0.f};
#pragma unroll
                for (int kn = 0; kn < 4; ++kn) { const bf16x8 hfr = *(const LAS bf16x8*)(Hl + (16 * pp + l15) * 136 + 32 * kn + 8 * quad);
                    acc = __builtin_amdgcn_mfma_f32_16x16x32_bf16(Cfr[kn], hfr, acc, 0, 0, 0); }
                const f32x4 ec = *(const LAS f32x4*)(sc + 128 + 16 * tt + 4 * quad);
                acc = acc * ec;
#pragma unroll
                for (int ks = 0; ks < 2; ++ks) {
                    if (ks == 0 || tt >= 2) {
                        const bf16x8 mfr = *(const LAS bf16x8*)(Ml + (16 * tt + l15) * 72 + 32 * ks + 8 * quad);
                        const bf16x8 xfr = *(const LAS bf16x8*)(xdtT + (16 * pp + l15) * 72 + 32 * ks + 8 * quad);
                        acc = __builtin_amdgcn_mfma_f32_16x16x32_bf16(mfr, xfr, acc, 0, 0, 0);
                    }
                }
#pragma unroll
                for (int jj = 0; jj < 4; ++jj) { const int t = 16 * tt + 4 * quad + jj, p = 16 * pp + l15, tl = c * 64 + t;
                    const float yv = (acc[jj] + Dh * xs_nat[t * 68 + p]) * bf2f(zr[pi][jj]);
                    if (tl < L) Y[(size_t)(b * L + tl) * DSSM + h * 64 + p] = f2bf(yv); }
            }
            const float eL = sc[256];
#pragma unroll
            for (int i = 0; i < 4; ++i) { const int nt = wlo * 4 + i;
                f32x4 acc = hacc[i] * eL;
#pragma unroll
                for (int ks = 0; ks < 2; ++ks) {
                    const bf16x8 xfr = *(const LAS bf16x8*)(xdtT + (16 * tt + l15) * 72 + 32 * ks + 8 * quad);
                    const bf16x8 bfr = *(const LAS bf16x8*)(BtT + (16 * nt + l15) * 72 + 32 * ks + 8 * quad);
                    acc = __builtin_amdgcn_mfma_f32_16x16x32_bf16(xfr, bfr, acc, 0, 0, 0);
                }
                hacc[i] = acc; }
            ++stepctr;
        }
#undef SSD_LOAD_RAW
#pragma unroll
        for (int i = 0; i < 4; ++i)
#pragma unroll
            for (int jj = 0; jj < 4; ++jj) hout[((size_t)(b * 64 + h) * 64 + 16 * tt + 4 * quad + jj) * 128 + 16 * (wlo * 4 + i) + l15] = hacc[i][jj];
    }
    __syncthreads();
}

#ifndef PH_MASK
#define PH_MASK 0xFFFF
#endif
#define PH(k) if ((PH_MASK >> (k)) & 1)
struct Args { const float* in[24]; float* out; unsigned char* ws; };

__global__ void __launch_bounds__(512, 2) fwd_kernel(Args a) {
    extern __shared__ __attribute__((aligned(16))) unsigned char lds_raw[];
    LAS unsigned char* lds = (LAS unsigned char*)lds_raw;
    cg::grid_group grid = cg::this_grid();
    const int G = gridDim.x, tid = threadIdx.x, wave = __builtin_amdgcn_readfirstlane(tid >> 6), lane = tid & 63;
    const int gw = blockIdx.x * 8 + wave, NGW = G * 8;
    unsigned char* ws = a.ws;
    bf16_t* WIN = (bf16_t*)(ws + WS_WIN); bf16_t* WA = (bf16_t*)(ws + WS_WA); bf16_t* WB = (bf16_t*)(ws + WS_WB); bf16_t* WO = (bf16_t*)(ws + WS_WO);
    bf16_t* WUP = (bf16_t*)(ws + WS_WUP); bf16_t* WDN = (bf16_t*)(ws + WS_WDN);
    bf16_t* HB = (bf16_t*)(ws + WS_H); bf16_t* UB = (bf16_t*)(ws + WS_U); bf16_t* VB = (bf16_t*)(ws + WS_V); bf16_t* ZB = (bf16_t*)(ws + WS_Z);
    bf16_t* XB = (bf16_t*)(ws + WS_XBC); bf16_t* GB = (bf16_t*)(ws + WS_G); bf16_t* YB = (bf16_t*)(ws + WS_Y); float* DTB = (float*)(ws + WS_DT);
    float* TAILB = (float*)(ws + WS_TAIL); bf16_t* MGB = (bf16_t*)(ws + WS_MG); bf16_t* ACTB = (bf16_t*)(ws + WS_ACT);

    PH(0) {
        LAS float* scr = (LAS float*)(lds + wave * 8448);
        constexpr int I_IN = 32 * 578, I_A = 32 * 64, I_B = 64 * 64, I_O = 32 * 64, I_G = 32 * 176, I_U = 32 * 176, I_D = 88 * 64;
        constexpr int NITEMS = I_IN + I_A + I_B + I_O + I_G + I_U + I_D;
        for (int it = gw; it < NITEMS; it += NGW) {
            int r = it;
            if (r < I_IN) { transpose_item(a.in[5], 2048, 18496, WIN, scr, r, lane, 1, nullptr); continue; } r -= I_IN;
            if (r < I_A) { transpose_item(a.in[10], 2048, 2048, WA, scr, r, lane, 0, nullptr); continue; } r -= I_A;
            if (r < I_B) { transpose_item(a.in[17], 4096, 2048, WB, scr, r, lane, 0, a.in[16]); continue; } r -= I_B;
            if (r < I_O) { transpose_item(a.in[18], 2048, 2048, WO, scr, r, lane, 0, nullptr); continue; } r -= I_O;
            if (r < I_G) { transpose_item(a.in[20], 2048, 5632, WUP, scr, r, lane, 2, nullptr); continue; } r -= I_G;
            if (r < I_U) { transpose_item(a.in[21], 2048, 5632, WUP, scr, r, lane, 3, nullptr); continue; } r -= I_U;
            transpose_item(a.in[22], 5632, 2048, WDN, scr, r, lane, 0, nullptr);
        }
        u32x4* zp = (u32x4*)(WIN + (size_t)18496 * 2048);
        for (int i = blockIdx.x * 512 + tid; i < 192 * 2048 / 8; i += G * 512) zp[i] = (u32x4){0u, 0u, 0u, 0u};
    }

    for (int s = 0; s < 3; ++s) {
        const bool smp = (s == 2);
        const int R = smp ? 512 : 16384, nb = smp ? 32 : 4, L = smp ? 16 : 4096;
        RowMap rm; rm.Ls = smp ? 4 : 12; rm.Lfull = smp ? 16 : 8192; rm.toff = smp ? 0 : s * 4096;
        const float* xin = smp ? a.in[1] : a.in[0];
        float* yout = a.out + (smp ? O_YS : O_YP);
        const float* hist = smp ? a.in[3] : (s == 1 ? TAILB : nullptr);
        const float* h0 = smp ? a.in[2] : (s == 1 ? a.out + O_SSMP : nullptr);
        float* hout = a.out + (smp ? O_SSMS : O_SSMP);
        float* taildst = smp ? a.out + O_CONVS : (s == 1 ? a.out + O_CONVP : TAILB);

        PH(1) rmsnorm_rows_bf16(xin, rm, a.in[4], HB, R, gw, NGW, lane);
        grid.sync();
        PH(2) { pg8::Gemm g{HB, WIN, R, NIN_PAD, 2048}; pg8::StaticOrder S; S.init(R, NIN_PAD, G, (int)blockIdx.x);
          EpiInProj E{UB, VB, ZB, XB, GB, DTB, a.in[13]};
          pg8::gemm_phase<EpiInProj, pg8::StaticOrder>(lds, g, S, E, nullptr); }
        grid.sync();
        PH(3) ln_rows(VB, a.in[6], a.in[7], smp ? a.out + O_VS : nullptr, R, gw, NGW, lane);
        for (int i = blockIdx.x * 512 + tid; i < nb * 3 * CONVD; i += G * 512) { const int bb = i / (3 * CONVD), rem = i % (3 * CONVD), rr = rem / CONVD, cc = rem % CONVD;
            taildst[i] = bf2f(XB[(size_t)(bb * L + L - 3 + rr) * CONVD + cc]); }
        grid.sync();
        PH(4) sgu_phase(lds, UB, VB, HB, a.in[8], a.in[9], smp ? 32 : 128, smp ? 16 : 128, G);
        PH(5) ssd_phase(lds, XB, DTB, ZB, YB, hist, h0, hout, a.in[11], a.in[12], a.in[14], a.in[15], nb, L, G);
        grid.sync();
        PH(6) gnorm_rows(YB, R, gw, NGW, lane);
        grid.sync();
        PH(7) { pg8::Gemm g{HB, WA, R, 2048, 2048}; pg8::StaticOrder S; S.init(R, 2048, G, (int)blockIdx.x);
          EpiGate<false> E{MGB, GB, 0};
          pg8::gemm_phase<EpiGate<false>, pg8::StaticOrder>(lds, g, S, E, nullptr); }
        grid.sync();
        PH(8) { pg8::Gemm g{YB, WB, R, 2048, 4096}; pg8::StaticOrder S; S.init(R, 2048, G, (int)blockIdx.x);
          EpiGate<true> E{MGB, GB, 2048};
          pg8::gemm_phase<EpiGate<true>, pg8::StaticOrder>(lds, g, S, E, nullptr); }
        grid.sync();
        PH(9) { pg8::Gemm g{MGB, WO, R, 2048, 2048}; pg8::StaticOrder S; S.init(R, 2048, G, (int)blockIdx.x);
          EpiResid E{xin, yout, rm};
          pg8::gemm_phase<EpiResid, pg8::StaticOrder>(lds, g, S, E, nullptr); }
        grid.sync();
        PH(10) rmsnorm_rows_bf16(yout, rm, a.in[19], HB, R, gw, NGW, lane);
        grid.sync();
        PH(11) { pg8::Gemm g{HB, WUP, R, 2 * DFF, 2048}; pg8::StaticOrder S; S.init(R, 2 * DFF, G, (int)blockIdx.x);
          EpiSwiGLU E{ACTB};
          pg8::gemm_phase<EpiSwiGLU, pg8::StaticOrder>(lds, g, S, E, nullptr); }
        grid.sync();
        PH(12) { pg8::Gemm g{ACTB, WDN, R, 2048, DFF}; pg8::StaticOrder S; S.init(R, 2048, G, (int)blockIdx.x);
          EpiResid E{yout, yout, rm};
          pg8::gemm_phase<EpiResid, pg8::StaticOrder>(lds, g, S, E, nullptr); }
        grid.sync();
        PH(13) rmsnorm_rows_inplace(yout, rm, a.in[23], R, gw, NGW, lane);
    }
}

extern "C" void kernel_launch(void* const* d_in, const int* in_sizes, int n_in, void* d_out, int out_size, void* d_ws, size_t ws_size, hipStream_t stream) {
    static int grid_blocks = 0;
    if (!grid_blocks) {
        int dev = 0, cus = 0, per_cu = 0;
        hipGetDevice(&dev);
        hipDeviceGetAttribute(&cus, hipDeviceAttributeMultiprocessorCount, dev);
        hipFuncSetAttribute((const void*)fwd_kernel, hipFuncAttributeMaxDynamicSharedMemorySize, LDS_BYTES);
        hipOccupancyMaxActiveBlocksPerMultiprocessor(&per_cu, (const void*)fwd_kernel, 512, LDS_BYTES);
        if (per_cu < 1) per_cu = 1;
        grid_blocks = cus * per_cu;
        if (ws_size < WS_END || n_in != 24) fprintf(stderr, "kernel_launch: unexpected ws_size %zu (need %zu) or n_in %d\n", ws_size, (size_t)WS_END, n_in);
    }
    Args a{};
    for (int i = 0; i < 24; ++i) a.in[i] = (const float*)d_in[i];
    a.out = (float*)d_out; a.ws = (unsigned char*)d_ws;
    void* args[] = {&a};
    hipError_t e = hipLaunchCooperativeKernel((const void*)fwd_kernel, dim3(grid_blocks), dim3(512), args, LDS_BYTES, stream);
    if (e != hipSuccess) fprintf(stderr, "cooperative launch failed: %s (grid %d)\n", hipGetErrorString(e), grid_blocks);
}
```

```cpp
#include <hip/hip_runtime.h>
#include <hip/hip_cooperative_groups.h>
#include <cstdio>
namespace cg = cooperative_groups;
namespace pg8 {
#define PG8_LAS __attribute__((address_space(3)))
typedef unsigned short bf16_t;
typedef short bf16x8 __attribute__((ext_vector_type(8)));
typedef float f32x4 __attribute__((ext_vector_type(4)));
typedef unsigned u32x4 __attribute__((ext_vector_type(4)));
constexpr int BM = 256, BK = 64, HALF = 128, HTB = HALF * BK * 2  , STAGE_BYTES = 8 * HTB, NXCD = 8, WGM = 8;

__host__ __device__ __forceinline__ int lds_byte(int r, int c) { const int st = (r >> 4) * 2 + (c >> 5), rr = r & 15, cc = c & 31, ob = rr * 64 + cc * 2; return st * 1024 + (ob ^ (((ob >> 9) & 1) << 5)); }
__host__ __device__ __forceinline__ void stage_rc(int b, int& R, int& C) { const int st = b / 1024, sb = b % 1024, swz = sb ^ (((sb >> 9) & 1) << 5); R = (st >> 1) * 16 + swz / 64; C = (st & 1) * 32 + (swz % 64) / 2; }
__host__ __device__ __forceinline__ int perm32(int rho) { const int n = rho >> 4, i = rho & 15; return 8 * (i >> 2) + 4 * n + (i & 3); }

struct Unit { int pm, pn; };
struct Gemm { const bf16_t* A; const bf16_t* Bt; int M, N, K; };

struct StaticOrder {
    int nM, nN, nwg, G, c;
    __host__ __device__ void init(int M, int N, int G_, int c_) { nM = M / BM; nN = N / BM; nwg = nM * nN; G = G_; c = c_; }
    __host__ __device__ bool next(int i, Unit& u) const {
        const long L = (long)i * G + c; if (L >= nwg) return false;
        int wgid = (int)L; { const int q = nwg / NXCD, r = nwg % NXCD, xcd = wgid % NXCD, off = wgid / NXCD; wgid = (xcd < r ? xcd * (q + 1) : r * (q + 1) + (xcd - r) * q) + off; }
        const int nig = WGM * nN, gid = wgid / nig, fm = gid * WGM, gsz = (nM - fm) < WGM ? (nM - fm) : WGM;
        u.pm = fm + ((wgid % nig) % gsz); u.pn = (wgid % nig) / gsz; return true;
    }
    __device__ __forceinline__ void a_ready(const Unit&) const {}
    __device__ __forceinline__ void done(const Unit&) const {}
};
__device__ __forceinline__ unsigned cvt_pk_bf16(float lo, float hi) { unsigned r; asm volatile("v_cvt_pk_bf16_f32 %0, %1, %2" : "=v"(r) : "v"(lo), "v"(hi)); return r; }
template <class Epi, class Sched, bool STAMP = false>
__device__ __forceinline__ void gemm_phase(PG8_LAS unsigned char* lds, const Gemm g, const Sched& S, const Epi& E, unsigned long long* stamps) {
    int tid_l = threadIdx.x; asm volatile("" : "+v"(tid_l));
    const int tid = tid_l, wid = __builtin_amdgcn_readfirstlane(tid >> 6), lane = tid & 63, wr = wid >> 2, wc = wid & 3, fr = lane & 15, fq = lane >> 4;
    const int K = g.K, nt = K / BK;
    int ts_lo = 0, ts_hi = 0, nts = 0; const unsigned long long rt_entry = STAMP ? (unsigned long long)wall_clock64() : 0ull;
#define PG8_STAMP() do { if (STAMP && wid == 0 && nts < 64) { const unsigned long long _c = (unsigned long long)clock64(); \
        ts_lo = (lane == nts) ? (int)(unsigned)_c : ts_lo; ts_hi = (lane == nts) ? (int)(unsigned)(_c >> 32) : ts_hi; ++nts; } } while (0)
    PG8_STAMP();
    unsigned voffA[2], voffB[2];
#pragma unroll
    for (int i = 0; i < 2; ++i) { int R, C; stage_rc(tid * 16 + i * 8192, R, C); const int Rb = Epi::PERM ? ((R & ~31) + perm32(R & 31)) : R;
        voffA[i] = (unsigned)(R * K + C) * 2u; voffB[i] = (unsigned)(Rb * K + C) * 2u; }
    const size_t kstep = (size_t)(BK * 2);
    const size_t hstep = (size_t)HALF * K * 2;
    const size_t tstep = 2 * hstep;
    const unsigned ldsw = (unsigned)wid * 1024u;
    const int aoff = lds_byte(wr * 64 + fr, fq * 8), boff = lds_byte(wc * 32 + fr, fq * 8);
#define PG8_SA(b, h) (((b) * 2 + (h)) * HTB)
#define PG8_SB(b, h) ((4 + (b) * 2 + (h)) * HTB)
#define PG8_STAGE(bufoff, gbase, voff) do { _Pragma("unroll") for (int _i = 0; _i < 2; ++_i) \
        __builtin_amdgcn_global_load_lds((const unsigned*)((const char*)(gbase) + (voff)[_i]), (PG8_LAS unsigned*)(lds + (bufoff) + ldsw + _i * 8192), 16, 0, 0); } while (0)
#define PG8_LDA(dst, b, h) do { _Pragma("unroll") for (int m = 0; m < 4; ++m) _Pragma("unroll") for (int k = 0; k < 2; ++k) dst[m][k] = *(const PG8_LAS bf16x8*)(lds + PG8_SA(b, h) + aoff + m * 2048 + k * 1024); } while (0)
#define PG8_LDB(dst, b, h) do { _Pragma("unroll") for (int n = 0; n < 2; ++n) _Pragma("unroll") for (int k = 0; k < 2; ++k) dst[n][k] = *(const PG8_LAS bf16x8*)(lds + PG8_SB(b, h) + boff + n * 2048 + k * 1024); } while (0)
#define PG8_MMA(ai, bj, At, Bt) do { __builtin_amdgcn_s_setprio(1); _Pragma("unroll") for (int m = 0; m < 4; ++m) _Pragma("unroll") for (int n = 0; n < 2; ++n) _Pragma("unroll") for (int k = 0; k < 2; ++k) \
        acc[ai][bj][m][n] = __builtin_amdgcn_mfma_f32_16x16x32_bf16(Bt[n][k], At[m][k], acc[ai][bj][m][n], 0, 0, 0); __builtin_amdgcn_s_setprio(0); } while (0)
#define PG8_WAIT_V(n) asm volatile("s_waitcnt vmcnt(" #n ")" ::: "memory")
#define PG8_WAIT_L(n) asm volatile("s_waitcnt lgkmcnt(" #n ")" ::: "memory")
#define PG8_BAR __builtin_amdgcn_s_barrier()
#define PG8_SCHED __builtin_amdgcn_sched_barrier(0)
    Unit cur, nxt; int ui = 0;
    if (!S.next(0, cur)) return;
    f32x4 acc[2][2][4][2];
#pragma unroll
    for (int a = 0; a < 2; ++a)
#pragma unroll
        for (int b = 0; b < 2; ++b)
#pragma unroll
            for (int m = 0; m < 4; ++m)
#pragma unroll
                for (int n = 0; n < 2; ++n) acc[a][b][m][n] = (f32x4){0.f, 0.f, 0.f, 0.f};
    bf16x8 At[4][2], B0[2][2], B1[2][2];
    const char* cA = (const char*)g.A + (size_t)cur.pm * tstep; const char* cB = (const char*)g.Bt + (size_t)cur.pn * tstep;
    S.a_ready(cur);
    PG8_STAGE(PG8_SB(0, 0), cB, voffB); PG8_STAGE(PG8_SA(0, 0), cA, voffA); PG8_STAGE(PG8_SB(0, 1), cB + hstep, voffB); PG8_STAGE(PG8_SA(0, 1), cA + hstep, voffA);
    if (wr == 1) PG8_BAR;
    PG8_WAIT_V(4); PG8_BAR;
    PG8_STAGE(PG8_SB(1, 0), cB + kstep, voffB); PG8_STAGE(PG8_SA(1, 0), cA + kstep, voffA); PG8_STAGE(PG8_SB(1, 1), cB + hstep + kstep, voffB);
    PG8_WAIT_V(6); PG8_BAR;
    PG8_STAMP();
    for (;;) {
        const bool has_next = S.next(ui + 1, nxt);
        const char* nA = has_next ? (const char*)g.A + (size_t)nxt.pm * tstep : cA; const char* nB = has_next ? (const char*)g.Bt + (size_t)nxt.pn * tstep : cB;
        for (int t = 0; t < nt; t += 2) {
            const bool last = (t == nt - 2);
            const char* a1 = cA + (size_t)(t + 1) * kstep;
            const char* a2 = last ? nA : cA + (size_t)(t + 2) * kstep; const char* b2 = last ? nB : cB + (size_t)(t + 2) * kstep;
            const char* a3 = a2 + kstep; const char* b3 = b2 + kstep;
            if (last && has_next) S.a_ready(nxt);
            PG8_LDB(B0, 0, 0); PG8_SCHED; PG8_LDA(At, 0, 0); PG8_STAGE(PG8_SA(1, 1), a1 + hstep, voffA);
            PG8_WAIT_L(8); PG8_BAR; PG8_WAIT_L(0); PG8_MMA(0, 0, At, B0); PG8_BAR; PG8_SCHED;
            PG8_LDB(B1, 0, 1); PG8_STAGE(PG8_SB(0, 0), b2, voffB);
            PG8_BAR; PG8_WAIT_L(0); PG8_MMA(0, 1, At, B1); PG8_BAR;
            PG8_LDA(At, 0, 1); PG8_STAGE(PG8_SA(0, 0), a2, voffA);
            PG8_BAR; PG8_WAIT_L(0); PG8_MMA(1, 0, At, B0); PG8_BAR; PG8_SCHED;
            PG8_STAGE(PG8_SB(0, 1), b2 + hstep, voffB);
            PG8_WAIT_V(6); PG8_BAR; PG8_MMA(1, 1, At, B1); PG8_BAR;
            PG8_LDB(B0, 1, 0); PG8_SCHED; PG8_LDA(At, 1, 0); PG8_STAGE(PG8_SA(0, 1), a2 + hstep, voffA);
            PG8_WAIT_L(8); PG8_BAR; PG8_WAIT_L(0); PG8_MMA(0, 0, At, B0); PG8_BAR; PG8_SCHED;
            PG8_LDB(B1, 1, 1); PG8_STAGE(PG8_SB(1, 0), b3, voffB);
            PG8_BAR; PG8_WAIT_L(0); PG8_MMA(0, 1, At, B1); PG8_BAR;
            PG8_LDA(At, 1, 1); PG8_STAGE(PG8_SA(1, 0), a3, voffA);
            PG8_BAR; PG8_WAIT_L(0); PG8_MMA(1, 0, At, B0); PG8_BAR; PG8_SCHED;
            PG8_STAGE(PG8_SB(1, 1), b3 + hstep, voffB);
            PG8_WAIT_V(6); PG8_BAR; PG8_MMA(1, 1, At, B1); PG8_BAR;
        }
        PG8_STAMP();
        if constexpr (!Epi::AFTER_DRAIN) { E(acc, cur, wr, wc, fr, fq); S.done(cur); }
        PG8_STAMP();
        if (!has_next) break;
#pragma unroll
        for (int a = 0; a < 2; ++a)
#pragma unroll
            for (int b = 0; b < 2; ++b)
#pragma unroll
                for (int m = 0; m < 4; ++m)
#pragma unroll
                    for (int n = 0; n < 2; ++n) acc[a][b][m][n] = (f32x4){0.f, 0.f, 0.f, 0.f};
        cur = nxt; cA = nA; cB = nB; ++ui;
    }
    PG8_WAIT_V(0);
    if (wr == 0) PG8_BAR;
    PG8_BAR;
    if constexpr (Epi::AFTER_DRAIN) { E.fused(acc, cur, wr, wc, fr, fq, lds, wid, lane); S.done(cur); }
    PG8_STAMP();
    if (STAMP && wid == 0) { stamps[lane] = lane < nts ? (((unsigned long long)(unsigned)ts_hi << 32) | (unsigned)ts_lo) : 0ull;
        if (lane == 62) stamps[62] = rt_entry; if (lane == 63) stamps[63] = (unsigned long long)wall_clock64(); }
#undef PG8_STAMP
#undef PG8_SA
#undef PG8_SB
#undef PG8_STAGE
#undef PG8_LDA
#undef PG8_LDB
#undef PG8_MMA
#undef PG8_WAIT_V
#undef PG8_WAIT_L
#undef PG8_BAR
#undef PG8_SCHED
}
}

using pg8::bf16_t; using pg8::bf16x8; using pg8::f32x4; using pg8::u32x4;
typedef unsigned u32x2 __attribute__((ext_vector_type(2)));
#define LAS __attribute__((address_space(3)))

constexpr int DM = 2048, DSSM = 4096, CONVD = 6144, NHEAD = 64, DFF = 5632, NIN_PAD = 18688;
constexpr float EPSN = 1e-6f;
constexpr size_t MiB = (size_t)1 << 20;
constexpr size_t WS_WIN = 0, WS_WA = 73 * MiB, WS_WB = 81 * MiB, WS_WO = 97 * MiB, WS_WUP = 105 * MiB, WS_WDN = 149 * MiB;
constexpr size_t WS_H = 171 * MiB, WS_U = 235 * MiB, WS_V = 299 * MiB, WS_Z = 363 * MiB, WS_XBC = 491 * MiB, WS_G = 683 * MiB, WS_Y = 811 * MiB, WS_DT = 939 * MiB, WS_TAIL = 943 * MiB, WS_SSQ = 943 * MiB + 512 * 1024, WS_BAR = 943 * MiB + 768 * 1024, WS_VST = 943 * MiB + 832 * 1024, WS_XBT = 944 * MiB, WS_SMP = 976 * MiB, WS_END = 1015 * MiB;
constexpr size_t WS_MG = WS_XBC, WS_ACT = WS_XBC;
constexpr size_t O_YP = 0, O_YS = 67108864, O_SSMP = 68157440, O_CONVP = 70254592, O_SSMS = 70328320, O_CONVS = 87105536, O_VS = 87695360;
constexpr int LDS_BYTES = 131072;

__device__ __forceinline__ float bflo(unsigned w) { return __uint_as_float(w << 16); }
__device__ __forceinline__ float bfhi(unsigned w) { return __uint_as_float(w & 0xffff0000u); }
__device__ __forceinline__ float bf2f(bf16_t b) { return __uint_as_float(((unsigned)b) << 16); }
typedef __bf16 bf16x2_t __attribute__((ext_vector_type(2)));
typedef float f32x2c __attribute__((ext_vector_type(2)));
__device__ __forceinline__ unsigned pk2(float lo, float hi) { const f32x2c v = (f32x2c){lo, hi}; const bf16x2_t b = __builtin_convertvector(v, bf16x2_t); return __builtin_bit_cast(unsigned, b); }
__device__ __forceinline__ bf16_t f2bf(float f) { return (bf16_t)(pk2(f, 0.f) & 0xffffu); }
__device__ __forceinline__ float sigm(float a) { return __builtin_amdgcn_rcpf(1.0f + __expf(-a)); }
__device__ __forceinline__ float wave_sum(float v) {
#pragma unroll
    for (int o = 1; o < 64; o <<= 1) v += __shfl_xor(v, o);
    return v;
}
struct RowMap { int Ls, Lfull, toff;
    __device__ __forceinline__ size_t operator()(int r) const { return (size_t)(r >> Ls) * Lfull + toff + (r & ((1 << Ls) - 1)); } };

typedef float f32x2 __attribute__((ext_vector_type(2)));
__device__ __forceinline__ f32x2 exp2_2(f32x2 a) { f32x2 r; r.x = __builtin_amdgcn_exp2f(a.x); r.y = __builtin_amdgcn_exp2f(a.y); return r; }
__device__ __forceinline__ f32x2 rcp_2(f32x2 a) { f32x2 r; r.x = __builtin_amdgcn_rcpf(a.x); r.y = __builtin_amdgcn_rcpf(a.y); return r; }
__device__ __forceinline__ f32x2 sigm_2(f32x2 x) { return rcp_2(exp2_2(x * -1.4426950409f) + 1.0f); }
__device__ __forceinline__ f32x2 silu_2(f32x2 x) { return x * sigm_2(x); }
__device__ __forceinline__ f32x2 gelu_2(f32x2 x) { const f32x2 t = (x * x) * -0.10294324f + -2.3022082f; return x * rcp_2(exp2_2(x * t) + 1.0f); }
template <int KIND> __device__ __forceinline__ unsigned act_pk(float a, float b) {
    f32x2 v = (f32x2){a, b};
    if (KIND == 0) v = gelu_2(v); else if (KIND == 1) v = silu_2(v); else if (KIND == 3) v = sigm_2(v);
    return pk2(v.x, v.y);
}
template <int KIND> __device__ __forceinline__ void inproj_tile(const f32x4 (&acc)[2][2][4][2], bf16_t* base, int ldc, int row0, int col0) {
#pragma unroll
    for (int ai = 0; ai < 2; ++ai)
#pragma unroll
        for (int m = 0; m < 4; ++m) {
            bf16_t* rowp = base + (size_t)(row0 + ai * 128 + m * 16) * ldc + col0;
#pragma unroll
            for (int bj = 0; bj < 2; ++bj) {
                const f32x4 v0 = acc[ai][bj][m][0], v1 = acc[ai][bj][m][1];
                u32x4 w; w.x = act_pk<KIND>(v0[0], v0[1]); w.y = act_pk<KIND>(v0[2], v0[3]); w.z = act_pk<KIND>(v1[0], v1[1]); w.w = act_pk<KIND>(v1[2], v1[3]);
                *(u32x4*)(rowp + bj * 128) = w;
            }
        }
}
__device__ __forceinline__ void inproj_tile_vstats(const f32x4 (&acc)[2][2][4][2], bf16_t* base, int row0, int col0, float* vst, int fq) {
#pragma unroll
    for (int ai = 0; ai < 2; ++ai)
#pragma unroll
        for (int m = 0; m < 4; ++m) {
            const int r = row0 + ai * 128 + m * 16;
            bf16_t* rowp = base + (size_t)r * 2048 + col0;
            f32x2 s1 = (f32x2){0.f, 0.f}, s2 = (f32x2){0.f, 0.f};
#pragma unroll
            for (int bj = 0; bj < 2; ++bj) {
                const f32x4 v0 = acc[ai][bj][m][0], v1 = acc[ai][bj][m][1];
                const f32x2 a = gelu_2((f32x2){v0[0], v0[1]}), b = gelu_2((f32x2){v0[2], v0[3]}), c = gelu_2((f32x2){v1[0], v1[1]}), d = gelu_2((f32x2){v1[2], v1[3]});
                s1 += (a + b) + (c + d); s2 += (a * a + b * b) + (c * c + d * d);
                u32x4 w; w.x = pk2(a.x, a.y); w.y = pk2(b.x, b.y); w.z = pk2(c.x, c.y); w.w = pk2(d.x, d.y);
                *(u32x4*)(rowp + bj * 128) = w;
            }
            float t1 = s1.x + s1.y, t2 = s2.x + s2.y;
            t1 += __shfl_xor(t1, 16); t1 += __shfl_xor(t1, 32); t2 += __shfl_xor(t2, 16); t2 += __shfl_xor(t2, 32);
            if (fq == 0) { atomicAdd(vst + 2 * r, t1); atomicAdd(vst + 2 * r + 1, t2); }
        }
}
__device__ __forceinline__ float act_k(float x, int kind) {
    const float a = (kind == 0) ? 1.5957691216f * (x + 0.044715f * x * x * x) : x;
    const float s = sigm(a);
    return kind == 3 ? s : (kind == 2 ? x : x * s);
}
struct EpiInProj {
    static constexpr bool PERM = true, AFTER_DRAIN = false;
    bf16_t *U, *V, *Z, *XBC, *G; float* DT; const float* dt_bias; float* vst;
    __device__ __forceinline__ void operator()(const f32x4 (&acc)[2][2][4][2], const pg8::Unit& u, int wr, int wc, int fr, int fq) const {
        const int pn = u.pn; const int row0 = u.pm * 256 + wr * 64 + fr;
        if (pn == 72) {
            if (wc < 2) {
                const int cl = wc * 32 + 8 * fq;
                const f32x4 b0 = *(const f32x4*)(dt_bias + cl), b1 = *(const f32x4*)(dt_bias + cl + 4);
#pragma unroll
                for (int ai = 0; ai < 2; ++ai)
#pragma unroll
                    for (int m = 0; m < 4; ++m) {
                        float* rp = DT + (size_t)(row0 + ai * 128 + m * 16) * 64 + cl;
                        f32x4 v0 = acc[ai][0][m][0] + b0, v1 = acc[ai][0][m][1] + b1;
#pragma unroll
                        for (int j = 0; j < 4; ++j) { v0[j] = fmaxf(v0[j], 0.f) + log1pf(__expf(-fabsf(v0[j]))); v1[j] = fmaxf(v1[j], 0.f) + log1pf(__expf(-fabsf(v1[j]))); }
                        *(f32x4*)rp = v0; *(f32x4*)(rp + 4) = v1;
                    }
            }
            return;
        }
        int kind, ldc, colt; bf16_t* base;
        if (pn < 8) { kind = 0; base = U; ldc = 2048; colt = pn * 256; }
        else if (pn < 16) { kind = 0; base = V; ldc = 2048; colt = (pn - 8) * 256; }
        else if (pn < 32) { kind = 1; base = Z; ldc = 4096; colt = (pn - 16) * 256; }
        else if (pn < 56) { kind = 2; base = XBC; ldc = 6144; colt = (pn - 32) * 256; }
        else { kind = 3; base = G; ldc = 4096; colt = (pn - 56) * 256; }
        const int col0 = colt + wc * 32 + 8 * fq;
        if (pn >= 8 && pn < 16 && vst) inproj_tile_vstats(acc, base, row0, col0, vst, fq);
        else if (kind == 0) inproj_tile<0>(acc, base, ldc, row0, col0);
        else if (kind == 1) inproj_tile<1>(acc, base, ldc, row0, col0);
        else if (kind == 2) inproj_tile<2>(acc, base, ldc, row0, col0);
        else inproj_tile<3>(acc, base, ldc, row0, col0);
    }
};
struct EpiNull {
    static constexpr bool PERM = true, AFTER_DRAIN = false;
    float* sink;
    __device__ __forceinline__ void operator()(const f32x4 (&acc)[2][2][4][2], const pg8::Unit& u, int wr, int wc, int fr, int fq) const {
        float s = 0.f;
#pragma unroll
        for (int ai = 0; ai < 2; ++ai)
#pragma unroll
            for (int bj = 0; bj < 2; ++bj)
#pragma unroll
                for (int m = 0; m < 4; ++m)
#pragma unroll
                    for (int n = 0; n < 2; ++n) s += (acc[ai][bj][m][n][0] + acc[ai][bj][m][n][1]) + (acc[ai][bj][m][n][2] + acc[ai][bj][m][n][3]);
        sink[(size_t)(u.pm * 73 + u.pn) * 512 + threadIdx.x] = s;
    }
};
template <bool ACCUM> struct EpiGate {
    static constexpr bool PERM = true, AFTER_DRAIN = false;
    bf16_t* MG; const bf16_t* Gt; int goff;
    __device__ __forceinline__ void operator()(const f32x4 (&acc)[2][2][4][2], const pg8::Unit& u, int wr, int wc, int fr, int fq) const {
        const int row0 = u.pm * 256 + wr * 64 + fr, col0 = u.pn * 256 + wc * 32 + 8 * fq;
#pragma unroll
        for (int ai = 0; ai < 2; ++ai)
#pragma unroll
            for (int m = 0; m < 4; ++m) {
                const size_t r = (size_t)(row0 + ai * 128 + m * 16);
#pragma unroll
                for (int bj = 0; bj < 2; ++bj) {
                    const int c = col0 + bj * 128;
                    const u32x4 gw = *(const u32x4*)(Gt + r * 4096 + goff + c);
                    const f32x4 v0 = acc[ai][bj][m][0], v1 = acc[ai][bj][m][1];
                    float o0 = bflo(gw.x) * v0[0], o1 = bfhi(gw.x) * v0[1], o2 = bflo(gw.y) * v0[2], o3 = bfhi(gw.y) * v0[3];
                    float o4 = bflo(gw.z) * v1[0], o5 = bfhi(gw.z) * v1[1], o6 = bflo(gw.w) * v1[2], o7 = bfhi(gw.w) * v1[3];
                    bf16_t* dst = MG + r * 2048 + c;
                    if (ACCUM) { const u32x4 pw = *(const u32x4*)dst;
                        o0 += bflo(pw.x); o1 += bfhi(pw.x); o2 += bflo(pw.y); o3 += bfhi(pw.y); o4 += bflo(pw.z); o5 += bfhi(pw.z); o6 += bflo(pw.w); o7 += bfhi(pw.w); }
                    u32x4 w; w.x = pk2(o0, o1); w.y = pk2(o2, o3); w.z = pk2(o4, o5); w.w = pk2(o6, o7);
                    *(u32x4*)dst = w;
                }
            }
    }
};
struct EpiSwiGLU {
    static constexpr bool PERM = true, AFTER_DRAIN = false;
    bf16_t* ACT; const float* SSQ;
    __device__ __forceinline__ void operator()(const f32x4 (&acc)[2][2][4][2], const pg8::Unit& u, int wr, int wc, int fr, int fq) const {
        const int row0 = u.pm * 256 + wr * 64 + fr, j0 = u.pn * 128 + wc * 16 + 4 * fq;
#pragma unroll
        for (int ai = 0; ai < 2; ++ai)
#pragma unroll
            for (int m = 0; m < 4; ++m) {
                bf16_t* rowp = ACT + (size_t)(row0 + ai * 128 + m * 16) * DFF + j0;
                const float rs = rsqrtf(SSQ[row0 + ai * 128 + m * 16] * (1.f / 2048.f) + EPSN);
#pragma unroll
                for (int bj = 0; bj < 2; ++bj) {
                    const f32x4 g = acc[ai][bj][m][0] * rs, up = acc[ai][bj][m][1] * rs;
                    const f32x2 o0 = silu_2((f32x2){g[0], g[1]}) * (f32x2){up[0], up[1]}, o1 = silu_2((f32x2){g[2], g[3]}) * (f32x2){up[2], up[3]};
                    u32x2 w; w.x = pk2(o0.x, o0.y); w.y = pk2(o1.x, o1.y);
                    *(u32x2*)(rowp + bj * 64) = w;
                }
            }
    }
};
struct EpiResid {
    static constexpr bool PERM = false, AFTER_DRAIN = false;
    const float* base; float* out; RowMap rm;
    __device__ __forceinline__ void operator()(const f32x4 (&acc)[2][2][4][2], const pg8::Unit& u, int wr, int wc, int fr, int fq) const {
        const int row0 = u.pm * 256 + wr * 64 + fr, col0 = u.pn * 256 + wc * 32 + 4 * fq;
#pragma unroll
        for (int ai = 0; ai < 2; ++ai)
#pragma unroll
            for (int m = 0; m < 4; ++m) {
                const size_t off = rm(row0 + ai * 128 + m * 16) * 2048 + col0;
#pragma unroll
                for (int bj = 0; bj < 2; ++bj)
#pragma unroll
                    for (int n = 0; n < 2; ++n) {
                        const f32x4 b = *(const f32x4*)(base + off + bj * 128 + n * 16);
                        *(f32x4*)(out + off + bj * 128 + n * 16) = b + acc[ai][bj][m][n];
                    }
            }
    }
};

struct EpiResidNorm {
    static constexpr bool PERM = true, AFTER_DRAIN = false;
    const float* base; RowMap rm; bf16_t* X1; float* SSQ;
    __device__ __forceinline__ void operator()(const f32x4 (&acc)[2][2][4][2], const pg8::Unit& u, int wr, int wc, int fr, int fq) const {
        const int row0 = u.pm * 256 + wr * 64 + fr, col0 = u.pn * 256 + wc * 32 + 8 * fq;
#pragma unroll
        for (int ai = 0; ai < 2; ++ai)
#pragma unroll
            for (int m = 0; m < 4; ++m) {
                const int r = row0 + ai * 128 + m * 16;
                const size_t off = rm(r) * 2048 + col0;
                float ss = 0.f;
#pragma unroll
                for (int bj = 0; bj < 2; ++bj) {
                    const f32x4 b0 = *(const f32x4*)(base + off + bj * 128), b1 = *(const f32x4*)(base + off + bj * 128 + 4);
                    const f32x4 x0 = b0 + acc[ai][bj][m][0], x1 = b1 + acc[ai][bj][m][1];
                    ss += ((x0[0] * x0[0] + x0[1] * x0[1]) + (x0[2] * x0[2] + x0[3] * x0[3])) + ((x1[0] * x1[0] + x1[1] * x1[1]) + (x1[2] * x1[2] + x1[3] * x1[3]));
                    u32x4 w; w.x = pk2(x0[0], x0[1]); w.y = pk2(x0[2], x0[3]); w.z = pk2(x1[0], x1[1]); w.w = pk2(x1[2], x1[3]);
                    *(u32x4*)(X1 + (size_t)r * 2048 + col0 + bj * 128) = w;
                }
                ss += __shfl_xor(ss, 16); ss += __shfl_xor(ss, 32);
                if (fq == 0) atomicAdd(SSQ + r, ss);
            }
    }
};
struct EpiResidBf {
    static constexpr bool PERM = true, AFTER_DRAIN = false;
    const bf16_t* X1; bf16_t* X2; float* SSQ2;
    __device__ __forceinline__ void operator()(const f32x4 (&acc)[2][2][4][2], const pg8::Unit& u, int wr, int wc, int fr, int fq) const {
        const int row0 = u.pm * 256 + wr * 64 + fr, col0 = u.pn * 256 + wc * 32 + 8 * fq;
#pragma unroll
        for (int ai = 0; ai < 2; ++ai)
#pragma unroll
            for (int m = 0; m < 4; ++m) {
                const int r = row0 + ai * 128 + m * 16;
                float ss = 0.f;
#pragma unroll
                for (int bj = 0; bj < 2; ++bj) {
                    const size_t eo = (size_t)r * 2048 + col0 + bj * 128;
                    const u32x4 xw = *(const u32x4*)(X1 + eo);
                    const f32x4 a0 = acc[ai][bj][m][0], a1 = acc[ai][bj][m][1];
                    const float y0 = bflo(xw.x) + a0[0], y1 = bfhi(xw.x) + a0[1], y2 = bflo(xw.y) + a0[2], y3 = bfhi(xw.y) + a0[3];
                    const float y4 = bflo(xw.z) + a1[0], y5 = bfhi(xw.z) + a1[1], y6 = bflo(xw.w) + a1[2], y7 = bfhi(xw.w) + a1[3];
                    ss += ((y0 * y0 + y1 * y1) + (y2 * y2 + y3 * y3)) + ((y4 * y4 + y5 * y5) + (y6 * y6 + y7 * y7));
                    u32x4 w; w.x = pk2(y0, y1); w.y = pk2(y2, y3); w.z = pk2(y4, y5); w.w = pk2(y6, y7);
                    *(u32x4*)(X2 + eo) = w;
                }
                ss += __shfl_xor(ss, 16); ss += __shfl_xor(ss, 32);
                if (fq == 0) atomicAdd(SSQ2 + r, ss);
            }
    }
};
__device__ __forceinline__ void final_rows(const bf16_t* X2, const float* SSQ2, float* out, RowMap rm, const float* g, int R, int gw, int NGW, int lane) {
    asm volatile("" : "+v"(lane)); asm volatile("" : "+s"(gw));
    for (int r = gw; r < R; r += NGW) {
        const float rstd = rsqrtf(SSQ2[r] * (1.f / 2048.f) + EPSN);
        const u32x4* xr = (const u32x4*)(X2 + (size_t)r * 2048) + lane;
        float* o = out + rm(r) * 2048;
#pragma unroll
        for (int j = 0; j < 4; ++j) { const u32x4 w = xr[64 * j]; const int c = (lane + 64 * j) * 8;
            const f32x4 g0 = *(const f32x4*)(g + c), g1 = *(const f32x4*)(g + c + 4);
            *(f32x4*)(o + c) = (f32x4){bflo(w.x) * rstd * g0[0], bfhi(w.x) * rstd * g0[1], bflo(w.y) * rstd * g0[2], bfhi(w.y) * rstd * g0[3]};
            *(f32x4*)(o + c + 4) = (f32x4){bflo(w.z) * rstd * g1[0], bfhi(w.z) * rstd * g1[1], bflo(w.w) * rstd * g1[2], bfhi(w.w) * rstd * g1[3]}; }
    }
}

__device__ __forceinline__ void gbar(unsigned* ctr, unsigned& target, unsigned G) {
    asm volatile("s_waitcnt vmcnt(0)" ::: "memory");
    __syncthreads();
    if (threadIdx.x == 0) {
        target += G;
        __builtin_amdgcn_fence(__ATOMIC_RELEASE, "agent");
        asm volatile("s_waitcnt vmcnt(0)" ::: "memory");
        __hip_atomic_fetch_add(ctr, 1u, __ATOMIC_RELAXED, __HIP_MEMORY_SCOPE_AGENT);
        while (__hip_atomic_load(ctr, __ATOMIC_RELAXED, __HIP_MEMORY_SCOPE_AGENT) < target) __builtin_amdgcn_s_sleep(1);
        __builtin_amdgcn_fence(__ATOMIC_ACQUIRE, "agent");
        asm volatile("s_waitcnt vmcnt(0)" ::: "memory");
    }
    __syncthreads();
}

__device__ __forceinline__ void rmsnorm_rows_bf16(const float* src, RowMap rm, const float* g, bf16_t* dst, int R, int gw, int NGW, int lane) {
    asm volatile("" : "+v"(lane)); asm volatile("" : "+s"(gw));
    for (int r = gw; r < R; r += NGW) {
        const f32x4* xr = (const f32x4*)(src + rm(r) * 2048) + lane;
        f32x4 v[8]; float ss = 0.f;
#pragma unroll
        for (int j = 0; j < 8; ++j) { v[j] = xr[64 * j]; ss += (v[j].x * v[j].x + v[j].y * v[j].y) + (v[j].z * v[j].z + v[j].w * v[j].w); }
        const float rstd = rsqrtf(wave_sum(ss) * (1.f / 2048.f) + EPSN);
        u32x2* o = (u32x2*)(dst + (size_t)r * 2048) + lane;
#pragma unroll
        for (int j = 0; j < 8; ++j) { const f32x4 gg = ((const f32x4*)g)[lane + 64 * j];
            u32x2 w; w.x = pk2(v[j].x * rstd * gg.x, v[j].y * rstd * gg.y); w.y = pk2(v[j].z * rstd * gg.z, v[j].w * rstd * gg.w); o[64 * j] = w; }
    }
}
__device__ __forceinline__ void rmsnorm_rows_inplace(float* buf, RowMap rm, const float* g, int R, int gw, int NGW, int lane) {
    asm volatile("" : "+v"(lane)); asm volatile("" : "+s"(gw));
    for (int r = gw; r < R; r += NGW) {
        f32x4* xr = (f32x4*)(buf + rm(r) * 2048) + lane;
        f32x4 v[8]; float ss = 0.f;
#pragma unroll
        for (int j = 0; j < 8; ++j) { v[j] = xr[64 * j]; ss += (v[j].x * v[j].x + v[j].y * v[j].y) + (v[j].z * v[j].z + v[j].w * v[j].w); }
        const float rstd = rsqrtf(wave_sum(ss) * (1.f / 2048.f) + EPSN);
#pragma unroll
        for (int j = 0; j < 8; ++j) { const f32x4 gg = ((const f32x4*)g)[lane + 64 * j]; xr[64 * j] = v[j] * rstd * gg; }
    }
}
__device__ __forceinline__ void ln_rows(bf16_t* V, const float* lg, const float* lb, float* vout, int R, int gw, int NGW, int lane) {
    asm volatile("" : "+v"(lane)); asm volatile("" : "+s"(gw));
    for (int r = gw; r < R; r += NGW) {
        u32x4* vr = (u32x4*)(V + (size_t)r * 2048) + lane;
        float x[4][8]; float s = 0.f;
#pragma unroll
        for (int j = 0; j < 4; ++j) { const u32x4 w = vr[64 * j];
            x[j][0] = bflo(w.x); x[j][1] = bfhi(w.x); x[j][2] = bflo(w.y); x[j][3] = bfhi(w.y); x[j][4] = bflo(w.z); x[j][5] = bfhi(w.z); x[j][6] = bflo(w.w); x[j][7] = bfhi(w.w);
#pragma unroll
            for (int k = 0; k < 8; ++k) s += x[j][k]; }
        const float mu = wave_sum(s) * (1.f / 2048.f); float q = 0.f;
#pragma unroll
        for (int j = 0; j < 4; ++j)
#pragma unroll
            for (int k = 0; k < 8; ++k) { x[j][k] -= mu; q += x[j][k] * x[j][k]; }
        const float rstd = rsqrtf(wave_sum(q) * (1.f / 2048.f) + EPSN);
#pragma unroll
        for (int j = 0; j < 4; ++j) { const int c = (lane + 64 * j) * 8;
            const f32x4 g0 = *(const f32x4*)(lg + c), g1 = *(const f32x4*)(lg + c + 4), b0 = *(const f32x4*)(lb + c), b1 = *(const f32x4*)(lb + c + 4);
            f32x4 y0, y1;
            y0.x = x[j][0] * rstd * g0.x + b0.x; y0.y = x[j][1] * rstd * g0.y + b0.y; y0.z = x[j][2] * rstd * g0.z + b0.z; y0.w = x[j][3] * rstd * g0.w + b0.w;
            y1.x = x[j][4] * rstd * g1.x + b1.x; y1.y = x[j][5] * rstd * g1.y + b1.y; y1.z = x[j][6] * rstd * g1.z + b1.z; y1.w = x[j][7] * rstd * g1.w + b1.w;
            u32x4 w; w.x = pk2(y0.x, y0.y); w.y = pk2(y0.z, y0.w); w.z = pk2(y1.x, y1.y); w.w = pk2(y1.z, y1.w); vr[64 * j] = w;
            if (vout) { float* o = vout + (size_t)r * 2048 + c; *(f32x4*)o = y0; *(f32x4*)(o + 4) = y1; } }
    }
}
__device__ __forceinline__ void gnorm_rows(bf16_t* Y, int R, int gw, int NGW, int lane) {
    asm volatile("" : "+v"(lane)); asm volatile("" : "+s"(gw));
    for (int r = gw; r < R; r += NGW) {
        u32x4* yr = (u32x4*)(Y + (size_t)r * 4096) + lane;
#pragma unroll
        for (int j = 0; j < 8; ++j) { const u32x4 w = yr[64 * j];
            float x0 = bflo(w.x), x1 = bfhi(w.x), x2 = bflo(w.y), x3 = bfhi(w.y), x4 = bflo(w.z), x5 = bfhi(w.z), x6 = bflo(w.w), x7 = bfhi(w.w);
            const float ss = (x0 * x0 + x1 * x1) + (x2 * x2 + x3 * x3) + (x4 * x4 + x5 * x5) + (x6 * x6 + x7 * x7);
            const float rstd = rsqrtf(wave_sum(ss) * (1.f / 512.f) + EPSN);
            u32x4 o; o.x = pk2(x0 * rstd, x1 * rstd); o.y = pk2(x2 * rstd, x3 * rstd); o.z = pk2(x4 * rstd, x5 * rstd); o.w = pk2(x6 * rstd, x7 * rstd); yr[64 * j] = o; }
    }
}

__device__ __forceinline__ int wt_rowmap(int mode, int n) {
    if (mode == 1) return n < 14336 ? n : (n < 14400 ? 18432 + (n - 14336) : n - 64);
    if (mode == 2) return 8 * (n >> 2) + (n & 3);
    if (mode == 3) return 8 * (n >> 2) + 4 + (n & 3);
    return n;
}
__device__ __forceinline__ void transpose_item(const float* W, int K, int N, bf16_t* WT, LAS bf16_t* scr, int item, int lane, int mode, const float* kscale) {
    const int nblk = N / 64, kb = item / nblk, nb = item % nblk, k0 = 64 * kb, n0 = 64 * nb;
    const int nl = 4 * (lane & 15), kq = 2 * (lane >> 4);
#pragma unroll
    for (int i = 0; i < 8; ++i) {
        const int ka = 8 * i + kq;
        f32x4 v0 = *(const f32x4*)(W + (size_t)(k0 + ka) * N + n0 + nl), v1 = *(const f32x4*)(W + (size_t)(k0 + ka + 1) * N + n0 + nl);
        if (kscale) { v0 = v0 * kscale[k0 + ka]; v1 = v1 * kscale[k0 + ka + 1]; }
#pragma unroll
        for (int j = 0; j < 4; ++j) *(LAS unsigned*)(scr + (nl + j) * 66 + ka) = pk2(v0[j], v1[j]);
    }
    asm volatile("s_waitcnt lgkmcnt(0)" ::: "memory");
    const int c = lane & 7;
#pragma unroll
    for (int j = 0; j < 8; ++j) { const int n = (lane >> 3) + 8 * j; const LAS unsigned* s = (const LAS unsigned*)(scr + n * 66 + 8 * c);
        u32x4 o; o.x = s[0]; o.y = s[1]; o.z = s[2]; o.w = s[3];
        *(u32x4*)(WT + (size_t)wt_rowmap(mode, n0 + n) * K + k0 + 8 * c) = o; }
    asm volatile("s_waitcnt lgkmcnt(0)" ::: "memory");
}
__device__ __forceinline__ void sgu_phase(LAS unsigned char* lds, const bf16_t* U, const bf16_t* VN, bf16_t* SA, const float* sgu_w, const float* sgu_b, int nchunks, int q, int G, const float* vst, const float* ln_g, const float* ln_b) {
    int tid_l = threadIdx.x; asm volatile("" : "+v"(tid_l));
    const int tid = tid_l, wave = __builtin_amdgcn_readfirstlane(tid >> 6), lane = tid & 63, l15 = lane & 15, quad = lane >> 4;
    LAS bf16_t* Wl = (LAS bf16_t*)lds;
    LAS bf16_t* Vl = (LAS bf16_t*)(lds + 128 * 136 * 2);
    const int nmt = q >> 4, nks = (q + 31) >> 5;
    int staged_g = -1;
    for (int unit = blockIdx.x; unit < nchunks * 8; unit += G) {
        const int chunk = unit >> 3, g = unit & 7, c0 = chunk * q;
        if (g != staged_g) {
            staged_g = g;
#pragma unroll
            for (int i = 0; i < 8; ++i) { const int ch = tid + 512 * i, t = ch >> 5, s4 = (ch & 31) * 4;
                const f32x4 w = *(const f32x4*)(sgu_w + ((size_t)(g * 128 + t) * 128 + s4));
                const bool tv = t < q;
                u32x2 o; o.x = pk2((tv && s4 <= t) ? w.x : 0.f, (tv && s4 + 1 <= t) ? w.y : 0.f); o.y = pk2((tv && s4 + 2 <= t) ? w.z : 0.f, (tv && s4 + 3 <= t) ? w.w : 0.f);
                *(LAS u32x2*)(Wl + t * 136 + s4) = o; }
        }
#pragma unroll
        for (int i = 0; i < 8; ++i) { const int ch = tid + 512 * i, s = ch >> 5, c8 = (ch & 31) * 8;
            u32x4 v = (u32x4){0u, 0u, 0u, 0u};
            if (s < q) v = *(const u32x4*)(VN + (size_t)(c0 + s) * 2048 + g * 256 + c8);
            if (vst && s < q) {
                const float mu = vst[2 * (c0 + s)] * (1.f / 2048.f), var = vst[2 * (c0 + s) + 1] * (1.f / 2048.f) - mu * mu, rstd = rsqrtf(var + EPSN);
                const f32x4 g0 = *(const f32x4*)(ln_g + g * 256 + c8), g1 = *(const f32x4*)(ln_g + g * 256 + c8 + 4), b0 = *(const f32x4*)(ln_b + g * 256 + c8), b1 = *(const f32x4*)(ln_b + g * 256 + c8 + 4);
                v.x = pk2((bflo(v.x) - mu) * rstd * g0[0] + b0[0], (bfhi(v.x) - mu) * rstd * g0[1] + b0[1]); v.y = pk2((bflo(v.y) - mu) * rstd * g0[2] + b0[2], (bfhi(v.y) - mu) * rstd * g0[3] + b0[3]);
                v.z = pk2((bflo(v.z) - mu) * rstd * g1[0] + b1[0], (bfhi(v.z) - mu) * rstd * g1[1] + b1[1]); v.w = pk2((bflo(v.w) - mu) * rstd * g1[2] + b1[2], (bfhi(v.w) - mu) * rstd * g1[3] + b1[3]); }
            *(LAS u32x4*)(Vl + s * 264 + c8) = v; }
        __syncthreads();
        f32x4 acc[8][2];
#pragma unroll
        for (int mt = 0; mt < 8; ++mt) { acc[mt][0] = (f32x4){0.f, 0.f, 0.f, 0.f}; acc[mt][1] = (f32x4){0.f, 0.f, 0.f, 0.f}; }
#pragma unroll
        for (int ks = 0; ks < 4; ++ks) {
            if (ks < nks) {
                bf16x8 bfr[2];
                { typedef unsigned short u16x4s __attribute__((ext_vector_type(4)));
                  u16x4s r00, r01, r10, r11;
                  const unsigned tb = (unsigned)(unsigned long)Vl + (unsigned)((32 * ks + 8 * quad + (l15 >> 2)) * 528 + (32 * wave + 4 * (lane & 3)) * 2);
                  asm volatile("ds_read_b64_tr_b16 %0, %4 offset:0\n\tds_read_b64_tr_b16 %1, %4 offset:2112\n\tds_read_b64_tr_b16 %2, %4 offset:32\n\tds_read_b64_tr_b16 %3, %4 offset:2144\n\ts_waitcnt lgkmcnt(0)"
                               : "=&v"(r00), "=&v"(r01), "=&v"(r10), "=&v"(r11) : "v"(tb) : "memory");
                  bfr[0][0] = (short)r00[0]; bfr[0][1] = (short)r00[1]; bfr[0][2] = (short)r00[2]; bfr[0][3] = (short)r00[3]; bfr[0][4] = (short)r01[0]; bfr[0][5] = (short)r01[1]; bfr[0][6] = (short)r01[2]; bfr[0][7] = (short)r01[3];
                  bfr[1][0] = (short)r10[0]; bfr[1][1] = (short)r10[1]; bfr[1][2] = (short)r10[2]; bfr[1][3] = (short)r10[3]; bfr[1][4] = (short)r11[0]; bfr[1][5] = (short)r11[1]; bfr[1][6] = (short)r11[2]; bfr[1][7] = (short)r11[3]; }
#pragma unroll
                for (int mt = 0; mt < 8; ++mt) {
                    if (mt < nmt && 16 * mt + 15 >= 32 * ks) {
                        const bf16x8 afr = *(const LAS bf16x8*)(Wl + (16 * mt + l15) * 136 + 32 * ks + 8 * quad);
                        acc[mt][0] = __builtin_amdgcn_mfma_f32_16x16x32_bf16(bfr[0], afr, acc[mt][0], 0, 0, 0);
                        acc[mt][1] = __builtin_amdgcn_mfma_f32_16x16x32_bf16(bfr[1], afr, acc[mt][1], 0, 0, 0);
                    }
                }
            }
        }
#pragma unroll
        for (int mt = 0; mt < 8; ++mt) {
            if (mt < nmt) {
                const int t = 16 * mt + l15; const size_t row = (size_t)(c0 + t); const float bias = sgu_b[g * 128 + t];
#pragma unroll
                for (int nt = 0; nt < 2; ++nt) { const int d0 = g * 256 + 32 * wave + 16 * nt + 4 * quad;
                    const u32x2 uw = *(const u32x2*)(U + row * 2048 + d0);
                    u32x2 o; o.x = pk2(bflo(uw.x) * (acc[mt][nt][0] + bias), bfhi(uw.x) * (acc[mt][nt][1] + bias)); o.y = pk2(bflo(uw.y) * (acc[mt][nt][2] + bias), bfhi(uw.y) * (acc[mt][nt][3] + bias));
                    *(u32x2*)(SA + row * 2048 + d0) = o; }
            }
        }
        __syncthreads();
    }
}

__device__ __forceinline__ void bcconv_phase(LAS unsigned char* lds, const bf16_t* XBC, bf16_t* XCBC, bf16_t* XBT, const float* hist, const float* conv_w, const float* conv_b, int nb, int L, int G) {
    int tid_l = threadIdx.x; asm volatile("" : "+v"(tid_l));
    const int tid = tid_l, wave = __builtin_amdgcn_readfirstlane(tid >> 6), lane = tid & 63;
    LAS bf16_t* T = (LAS bf16_t*)lds;
    const int nchunks = (L + 63) >> 6;
    const int qi = lane, run = wave;
    int cached_g = -1; f32x4 cb = (f32x4){0.f, 0.f, 0.f, 0.f}, cw[4] = {cb, cb, cb, cb};
    for (int unit = blockIdx.x; unit < nb * nchunks * 8; unit += G) {
        const int g = unit & 7, bc = unit >> 3, c = bc % nchunks, b = bc / nchunks;
        const int col = (qi < 32) ? 4096 + g * 128 + 4 * qi : 5120 + g * 128 + 4 * (qi - 32);
        const int ocol = (qi < 32) ? g * 128 + 4 * qi : 1024 + g * 128 + 4 * (qi - 32);
        if (g != cached_g) { cached_g = g; cb = *(const f32x4*)(conv_b + col);
#pragma unroll
            for (int k = 0; k < 4; ++k) cw[k] = *(const f32x4*)(conv_w + k * CONVD + col); }
        u32x2 raw[11];
#pragma unroll
        for (int i = 0; i < 11; ++i) { const int tl = c * 64 + 8 * run - 3 + i; u32x2 v = (u32x2){0u, 0u};
            if (tl < 0) { if (hist) { const f32x4 f = *(const f32x4*)(hist + (size_t)(b * 3 + 3 + tl) * CONVD + col); v.x = pk2(f.x, f.y); v.y = pk2(f.z, f.w); } }
            else if (tl < L) v = *(const u32x2*)(XBC + (size_t)(b * L + tl) * CONVD + col);
            raw[i] = v; }
        float sv[8][4];
#pragma unroll
        for (int i = 0; i < 8; ++i) {
            const int tl = c * 64 + 8 * run + i; const bool valid = tl < L;
            float v0 = cb.x, v1 = cb.y, v2 = cb.z, v3 = cb.w;
#pragma unroll
            for (int k = 0; k < 4; ++k) { const u32x2 rw = raw[i + k];
                v0 += bflo(rw.x) * cw[k].x; v1 += bfhi(rw.x) * cw[k].y; v2 += bflo(rw.y) * cw[k].z; v3 += bfhi(rw.y) * cw[k].w; }
            sv[i][0] = valid ? v0 * sigm(v0) : 0.f; sv[i][1] = valid ? v1 * sigm(v1) : 0.f; sv[i][2] = valid ? v2 * sigm(v2) : 0.f; sv[i][3] = valid ? v3 * sigm(v3) : 0.f;
            if (valid) { u32x2 o; o.x = pk2(sv[i][0], sv[i][1]); o.y = pk2(sv[i][2], sv[i][3]); *(u32x2*)(XCBC + (size_t)(b * L + tl) * 2048 + ocol) = o; }
        }
    }
}

__device__ __forceinline__ void ssd_phase(LAS unsigned char* lds, const bf16_t* XBC, const bf16_t* XCBC, const bf16_t* XBT, const float* DT, const bf16_t* Zs, bf16_t* Y,
                                          const float* hist, const float* h0, float* hout, const float* conv_w, const float* conv_b, const float* a_log, const float* d_skip,
                                          int nb, int L, int G) {
    int tid_l = threadIdx.x; asm volatile("" : "+v"(tid_l));
    const int tid = tid_l, wave = __builtin_amdgcn_readfirstlane(tid >> 6), lane = tid & 63, l15 = lane & 15, quad = lane >> 4;
    LAS float* xs_nat = (LAS float*)(lds);
    LAS bf16_t* xdtT = (LAS bf16_t*)(lds + 17408);
    LAS bf16_t* xtlT = (LAS bf16_t*)(lds + 26624);
    LAS bf16_t* Bnat = (LAS bf16_t*)(lds + 35840);
    LAS bf16_t* BT = (LAS bf16_t*)(lds + 53248);
    LAS bf16_t* Cnat = (LAS bf16_t*)(lds + 71680);
    LAS bf16_t* Ml = (LAS bf16_t*)(lds + 89088);
    LAS bf16_t* Hl = (LAS bf16_t*)(lds + 98304);
    LAS float* scal = (LAS float*)(lds + 115712);
    const int nchunks = (L + 63) >> 6;
    const int qi = tid & 15, rp = tid >> 4;
    const int tt = wave >> 1, wlo = wave & 1;
    int stepctr = 0;
    for (int unit0 = blockIdx.x; unit0 < nb * 64; unit0 += G) {
        int unit = unit0;
        if (G == 256) { const int x = unit0 & 255, slot = x >> 3; unit = (unit0 & ~255) + ((((x & 7) << 2) + (slot >> 3)) << 3) + (slot & 7); }
        const int b = unit >> 6, h = unit & 63, g = h >> 3;
        const float aneg = -__expf(a_log[h]), Dh = d_skip[h];
        const int col = h * 64 + 4 * qi;
        const f32x4 cb = *(const f32x4*)(conv_b + col);
        f32x4 cw[4];
#pragma unroll
        for (int k = 0; k < 4; ++k) cw[k] = *(const f32x4*)(conv_w + k * CONVD + col);
        f32x4 hacc[4];
#pragma unroll
        for (int i = 0; i < 4; ++i) {
            if (h0) hacc[i] = *(const f32x4*)(h0 + ((size_t)(b * 64 + h) * 64 + 16 * tt + l15) * 128 + 16 * (wlo * 4 + i) + 4 * quad);
            else hacc[i] = (f32x4){0.f, 0.f, 0.f, 0.f};
        }
        u32x2 raw[5]; u32x4 bq[2], cq[2]; float dtn = 0.f;
#define SSD_LOAD(cc) do { \
            _Pragma("unroll") for (int i = 0; i < 5; ++i) { const int tl = (cc) * 64 + 2 * rp - 3 + i; u32x2 v = (u32x2){0u, 0u}; \
                if (tl < 0) { if (hist) { const f32x4 f = *(const f32x4*)(hist + (size_t)(b * 3 + 3 + tl) * CONVD + col); v.x = pk2(f.x, f.y); v.y = pk2(f.z, f.w); } } \
                else if (tl < L) v = *(const u32x2*)(XBC + (size_t)(b * L + tl) * CONVD + col); \
                raw[i] = v; } \
            _Pragma("unroll") for (int j = 0; j < 2; ++j) { const int ch = tid + 512 * j, s = ch >> 4, c8 = (ch & 15) * 8, tl = (cc) * 64 + s; \
                bq[j] = (u32x4){0u, 0u, 0u, 0u}; cq[j] = (u32x4){0u, 0u, 0u, 0u}; \
                if (tl < L) { const bf16_t* src = XCBC + (size_t)(b * L + tl) * 2048 + g * 128 + c8; bq[j] = *(const u32x4*)src; cq[j] = *(const u32x4*)(src + 1024); } } \
            if (wave == 0) { const int tl = (cc) * 64 + lane; dtn = (tl < L) ? DT[(size_t)(b * L + tl) * 64 + h] : 0.f; } \
        } while (0)
        SSD_LOAD(0);
        for (int c = 0; c < nchunks; ++c) {
            LAS float* sc = scal + (stepctr & 1) * 320;
            if (wave == 0) {
                const float dtv = dtn; float cum = dtv * aneg;
#pragma unroll
                for (int o = 1; o < 64; o <<= 1) { const float v = __shfl_up(cum, o); if (lane >= o) cum += v; }
                const float cumL = __shfl(cum, 63);
                sc[lane] = dtv; sc[64 + lane] = cum; sc[128 + lane] = __expf(cum); sc[192 + lane] = dtv * __expf(cumL - cum);
                if (lane == 0) sc[256] = __expf(cumL);
            }
            u32x2 zr[2];
            { const int tl = c * 64 + 16 * tt + l15;
#pragma unroll
              for (int pi = 0; pi < 2; ++pi) zr[pi] = (tl < L) ? *(const u32x2*)(Zs + (size_t)(b * L + tl) * DSSM + h * 64 + 16 * (wlo * 2 + pi) + 4 * quad) : (u32x2){0u, 0u}; }
            __syncthreads();
            {
                float sv[2][4];
#pragma unroll
                for (int e = 0; e < 2; ++e) {
                    const bool valid = (c * 64 + 2 * rp + e) < L;
                    float v0 = cb.x, v1 = cb.y, v2 = cb.z, v3 = cb.w;
#pragma unroll
                    for (int k = 0; k < 4; ++k) { const u32x2 rw = raw[e + k];
                        v0 += bflo(rw.x) * cw[k].x; v1 += bfhi(rw.x) * cw[k].y; v2 += bflo(rw.y) * cw[k].z; v3 += bfhi(rw.y) * cw[k].w; }
                    sv[e][0] = valid ? v0 * sigm(v0) : 0.f; sv[e][1] = valid ? v1 * sigm(v1) : 0.f; sv[e][2] = valid ? v2 * sigm(v2) : 0.f; sv[e][3] = valid ? v3 * sigm(v3) : 0.f;
                }
                const int t = 2 * rp;
                *(LAS f32x4*)(xs_nat + t * 68 + 4 * qi) = (f32x4){sv[0][0], sv[0][1], sv[0][2], sv[0][3]};
                *(LAS f32x4*)(xs_nat + (t + 1) * 68 + 4 * qi) = (f32x4){sv[1][0], sv[1][1], sv[1][2], sv[1][3]};
                const float d0 = sc[t], d1 = sc[t + 1], e0 = sc[192 + t], e1 = sc[192 + t + 1];
                const int tsw = ((((t >> 3) ^ (qi & 7)) << 3) + (t & 7));
#pragma unroll
                for (int k = 0; k < 4; ++k) { *(LAS unsigned*)(xdtT + (4 * qi + k) * 72 + tsw) = pk2(sv[0][k] * d0, sv[1][k] * d1);
                    *(LAS unsigned*)(xtlT + (4 * qi + k) * 72 + tsw) = pk2(sv[0][k] * e0, sv[1][k] * e1); }
#pragma unroll
                for (int j = 0; j < 2; ++j) { const int ch = tid + 512 * j;
                    *(LAS u32x4*)(Bnat + (ch >> 4) * 136 + (ch & 15) * 8) = bq[j]; *(LAS u32x4*)(Cnat + (ch >> 4) * 136 + (ch & 15) * 8) = cq[j]; }
            }
            if (c + 1 < nchunks) SSD_LOAD(c + 1);
            __syncthreads();
            bf16x8 Cfr[4];
#pragma unroll
            for (int kn = 0; kn < 4; ++kn) Cfr[kn] = *(const LAS bf16x8*)(Cnat + (16 * tt + l15) * 136 + 32 * kn + 8 * quad);
            { const int t = 16 * tt + l15; const float ct = sc[64 + t];
#pragma unroll
              for (int si = 0; si < 2; ++si) { const int st = wlo * 2 + si;
                f32x4 acc = (f32x4){0.f, 0.f, 0.f, 0.f};
#pragma unroll
                for (int kn = 0; kn < 4; ++kn) { const bf16x8 bfr = *(const LAS bf16x8*)(Bnat + (16 * st + l15) * 136 + 32 * kn + 8 * quad);
                    acc = __builtin_amdgcn_mfma_f32_16x16x32_bf16(bfr, Cfr[kn], acc, 0, 0, 0); }
                const int s0 = 16 * st + 4 * quad; const f32x4 cs = *(const LAS f32x4*)(sc + 64 + s0);
                float m[4];
#pragma unroll
                for (int jj = 0; jj < 4; ++jj) m[jj] = (s0 + jj <= t) ? acc[jj] * __expf(ct - cs[jj]) : 0.f;
                u32x2 o; o.x = pk2(m[0], m[1]); o.y = pk2(m[2], m[3]);
                *(LAS u32x2*)(Ml + t * 72 + s0) = o; }
            }
#pragma unroll
            for (int i = 0; i < 4; ++i) { u32x2 o; o.x = pk2(hacc[i][0], hacc[i][1]); o.y = pk2(hacc[i][2], hacc[i][3]);
                *(LAS u32x2*)(Hl + (16 * tt + l15) * 136 + 16 * (wlo * 4 + i) + 4 * quad) = o; }
            __syncthreads();
            { const int t = 16 * tt + l15, tl = c * 64 + t; const float ec = sc[128 + t];
#pragma unroll
              for (int pi = 0; pi < 2; ++pi) { const int pp = wlo * 2 + pi;
                f32x4 acc = (f32x4){0.f, 0.f, 0.f, 0.f};
#pragma unroll
                for (int kn = 0; kn < 4; ++kn) { const bf16x8 hfr = *(const LAS bf16x8*)(Hl + (16 * pp + l15) * 136 + 32 * kn + 8 * quad);
                    acc = __builtin_amdgcn_mfma_f32_16x16x32_bf16(hfr, Cfr[kn], acc, 0, 0, 0); }
                acc = acc * ec;
#pragma unroll
                for (int ks = 0; ks < 2; ++ks) {
                    if (ks == 0 || tt >= 2) {
                        const bf16x8 xfr = *(const LAS bf16x8*)(xdtT + (16 * pp + l15) * 72 + (((4 * ks + quad) ^ (((16 * pp + l15) >> 2) & 7)) << 3));
                        const bf16x8 mfr = *(const LAS bf16x8*)(Ml + (16 * tt + l15) * 72 + 32 * ks + 8 * quad);
                        acc = __builtin_amdgcn_mfma_f32_16x16x32_bf16(xfr, mfr, acc, 0, 0, 0);
                    }
                }
                const int p0 = 16 * pp + 4 * quad;
                const f32x4 xs = *(const LAS f32x4*)(xs_nat + t * 68 + p0);
                const u32x2 zw = zr[pi];
                u32x2 o; o.x = pk2((acc[0] + Dh * xs[0]) * bflo(zw.x), (acc[1] + Dh * xs[1]) * bfhi(zw.x)); o.y = pk2((acc[2] + Dh * xs[2]) * bflo(zw.y), (acc[3] + Dh * xs[3]) * bfhi(zw.y));
                if (tl < L) *(u32x2*)(Y + (size_t)(b * L + tl) * DSSM + h * 64 + p0) = o; }
            }
            const float eL = sc[256];
            typedef unsigned short u16x4t __attribute__((ext_vector_type(4)));
            u16x4t tr[4][2][2];
            { const unsigned tb = (unsigned)(unsigned long)Bnat + (unsigned)((8 * quad + (l15 >> 2)) * 272 + (64 * wlo + 4 * (lane & 3)) * 2);
              asm volatile(
                "ds_read_b64_tr_b16 %0, %16 offset:0\n\t"    "ds_read_b64_tr_b16 %1, %16 offset:1088\n\t"
                "ds_read_b64_tr_b16 %2, %16 offset:8704\n\t" "ds_read_b64_tr_b16 %3, %16 offset:9792\n\t"
                "ds_read_b64_tr_b16 %4, %16 offset:32\n\t"   "ds_read_b64_tr_b16 %5, %16 offset:1120\n\t"
                "ds_read_b64_tr_b16 %6, %16 offset:8736\n\t" "ds_read_b64_tr_b16 %7, %16 offset:9824\n\t"
                "ds_read_b64_tr_b16 %8, %16 offset:64\n\t"   "ds_read_b64_tr_b16 %9, %16 offset:1152\n\t"
                "ds_read_b64_tr_b16 %10, %16 offset:8768\n\t" "ds_read_b64_tr_b16 %11, %16 offset:9856\n\t"
                "ds_read_b64_tr_b16 %12, %16 offset:96\n\t"  "ds_read_b64_tr_b16 %13, %16 offset:1184\n\t"
                "ds_read_b64_tr_b16 %14, %16 offset:8800\n\t" "ds_read_b64_tr_b16 %15, %16 offset:9888\n\t"
                "s_waitcnt lgkmcnt(0)"
                : "=&v"(tr[0][0][0]), "=&v"(tr[0][0][1]), "=&v"(tr[0][1][0]), "=&v"(tr[0][1][1]),
                  "=&v"(tr[1][0][0]), "=&v"(tr[1][0][1]), "=&v"(tr[1][1][0]), "=&v"(tr[1][1][1]),
                  "=&v"(tr[2][0][0]), "=&v"(tr[2][0][1]), "=&v"(tr[2][1][0]), "=&v"(tr[2][1][1]),
                  "=&v"(tr[3][0][0]), "=&v"(tr[3][0][1]), "=&v"(tr[3][1][0]), "=&v"(tr[3][1][1])
                : "v"(tb) : "memory"); }
#pragma unroll
            for (int i = 0; i < 4; ++i) {
                f32x4 acc = hacc[i] * eL;
#pragma unroll
                for (int ks = 0; ks < 2; ++ks) {
                    bf16x8 btf;
                    btf[0] = (short)tr[i][ks][0][0]; btf[1] = (short)tr[i][ks][0][1]; btf[2] = (short)tr[i][ks][0][2]; btf[3] = (short)tr[i][ks][0][3];
                    btf[4] = (short)tr[i][ks][1][0]; btf[5] = (short)tr[i][ks][1][1]; btf[6] = (short)tr[i][ks][1][2]; btf[7] = (short)tr[i][ks][1][3];
                    const bf16x8 xtf = *(const LAS bf16x8*)(xtlT + (16 * tt + l15) * 72 + (((4 * ks + quad) ^ (((16 * tt + l15) >> 2) & 7)) << 3));
                    acc = __builtin_amdgcn_mfma_f32_16x16x32_bf16(btf, xtf, acc, 0, 0, 0);
                }
                hacc[i] = acc; }
            ++stepctr;
        }
#undef SSD_LOAD
#pragma unroll
        for (int i = 0; i < 4; ++i) *(f32x4*)(hout + ((size_t)(b * 64 + h) * 64 + 16 * tt + l15) * 128 + 16 * (wlo * 4 + i) + 4 * quad) = hacc[i];
    }
    __syncthreads();
}

#ifndef PH_MASK
#define PH_MASK 0xFFFF
#endif
#define PH(k) if ((PH_MASK >> (k)) & 1)
#ifndef PROBE
#define PROBE 0
#endif
#define GBAR() do { gbar(barctr, bartgt, (unsigned)G); if ((PROBE >> 21) & 1) gbar(barctr, bartgt, (unsigned)G); } while (0)
#define PRB(bit) for (int prb_ = 0; prb_ < (((PROBE >> (bit)) & 1) ? 2 : 1); ++prb_)
struct Args { const float* in[24]; float* out; unsigned char* ws; };

__global__ void __launch_bounds__(512, 2) fwd_kernel(Args a) {
    extern __shared__ __attribute__((aligned(16))) unsigned char lds_raw[];
    LAS unsigned char* lds = (LAS unsigned char*)lds_raw;
    cg::grid_group grid = cg::this_grid();
    const int G = gridDim.x, tid = threadIdx.x, wave = __builtin_amdgcn_readfirstlane(tid >> 6), lane = tid & 63;
    const int gw = blockIdx.x * 8 + wave, NGW = G * 8;
    unsigned char* ws = a.ws;
    bf16_t* WIN = (bf16_t*)(ws + WS_WIN); bf16_t* WA = (bf16_t*)(ws + WS_WA); bf16_t* WB = (bf16_t*)(ws + WS_WB); bf16_t* WO = (bf16_t*)(ws + WS_WO);
    bf16_t* WUP = (bf16_t*)(ws + WS_WUP); bf16_t* WDN = (bf16_t*)(ws + WS_WDN);
    bf16_t* HB = (bf16_t*)(ws + WS_H); bf16_t* UB = (bf16_t*)(ws + WS_U); bf16_t* VB = (bf16_t*)(ws + WS_V); bf16_t* ZB = (bf16_t*)(ws + WS_Z);
    bf16_t* XB = (bf16_t*)(ws + WS_XBC); bf16_t* GB = (bf16_t*)(ws + WS_G); bf16_t* YB = (bf16_t*)(ws + WS_Y); float* DTB = (float*)(ws + WS_DT);
    float* TAILB = (float*)(ws + WS_TAIL); bf16_t* MGB = (bf16_t*)(ws + WS_MG); bf16_t* ACTB = (bf16_t*)(ws + WS_ACT);
    bf16_t* XCBC = (bf16_t*)(ws + WS_H); bf16_t* XBT = (bf16_t*)(ws + WS_XBT); float* SSQ = (float*)(ws + WS_SSQ);
    unsigned* barctr = (unsigned*)(ws + WS_BAR); unsigned bartgt = 0;
    float* VST = (float*)(ws + WS_VST);

    {
        LAS bf16_t* scr = (LAS bf16_t*)(lds + wave * 8448);
        constexpr int I_IN = 32 * 289, I_A = 32 * 32, I_B = 64 * 32, I_O = 32 * 32, I_G = 32 * 88, I_U = 32 * 88, I_D = 88 * 32;
        constexpr int NITEMS = I_IN + I_A + I_B + I_O + I_G + I_U + I_D;
        for (int it = gw; it < NITEMS; it += NGW) {
            int r = it;
            if (r < I_IN) { transpose_item(a.in[5], 2048, 18496, WIN, scr, r, lane, 1, nullptr); continue; } r -= I_IN;
            if (r < I_A) { transpose_item(a.in[10], 2048, 2048, WA, scr, r, lane, 0, nullptr); continue; } r -= I_A;
            if (r < I_B) { transpose_item(a.in[17], 4096, 2048, WB, scr, r, lane, 0, a.in[16]); continue; } r -= I_B;
            if (r < I_O) { transpose_item(a.in[18], 2048, 2048, WO, scr, r, lane, 0, nullptr); continue; } r -= I_O;
            if (r < I_G) { transpose_item(a.in[20], 2048, 5632, WUP, scr, r, lane, 2, a.in[19]); continue; } r -= I_G;
            if (r < I_U) { transpose_item(a.in[21], 2048, 5632, WUP, scr, r, lane, 3, a.in[19]); continue; } r -= I_U;
            transpose_item(a.in[22], 5632, 2048, WDN, scr, r, lane, 0, nullptr);
        }
        u32x4* zp = (u32x4*)(WIN + (size_t)18496 * 2048);
        for (int i = blockIdx.x * 512 + tid; i < 192 * 2048 / 8; i += G * 512) zp[i] = (u32x4){0u, 0u, 0u, 0u};
    }

    unsigned char* sws = ws + WS_SMP;
    for (int s = 0; s < 2; ++s) {
        const int nsub = s + 1;
#define SUB_PARAMS(j) \
        const bool smp = ((j) == 1); \
        const int R = smp ? 512 : 16384, nb = smp ? 32 : 4, L = smp ? 16 : 4096; \
        RowMap rm; rm.Ls = smp ? 4 : 12; rm.Lfull = smp ? 16 : 8192; rm.toff = smp ? 0 : s * 4096; \
        const float* xin = smp ? a.in[1] : a.in[0]; \
        float* yout = a.out + (smp ? O_YS : O_YP); \
        const float* hist = smp ? a.in[3] : (s == 1 ? TAILB : nullptr); \
        const float* h0 = smp ? a.in[2] : (s == 1 ? a.out + O_SSMP : nullptr); \
        float* hout = a.out + (smp ? O_SSMS : O_SSMP); \
        float* taildst = smp ? a.out + O_CONVS : (s == 1 ? a.out + O_CONVP : TAILB); \
        bf16_t* bH = smp ? (bf16_t*)(sws + 0 * MiB) : HB;      \
        bf16_t* bU = smp ? (bf16_t*)(sws + 2 * MiB) : UB; \
        bf16_t* bV = smp ? (bf16_t*)(sws + 4 * MiB) : VB; \
        bf16_t* bZ = smp ? (bf16_t*)(sws + 6 * MiB) : ZB; \
        bf16_t* bX = smp ? (bf16_t*)(sws + 10 * MiB) : XB;     \
        bf16_t* bG = smp ? (bf16_t*)(sws + 16 * MiB) : GB; \
        bf16_t* bY = smp ? (bf16_t*)(sws + 20 * MiB) : YB; \
        float* bDT = smp ? (float*)(sws + 24 * MiB) : DTB; \
        bf16_t* bXC = smp ? (bf16_t*)(sws + 25 * MiB) : XCBC; \
        bf16_t* bXT = smp ? (bf16_t*)(sws + 27 * MiB) : XBT; \
        bf16_t* bMG = smp ? (bf16_t*)(sws + 31 * MiB) : MGB; \
        bf16_t* bACT = smp ? (bf16_t*)(sws + 33 * MiB) : ACTB; \
        float* bSSQ = smp ? SSQ + 16384 : SSQ; \
        (void)R; (void)nb; (void)L; (void)rm; (void)xin; (void)yout; (void)hist; (void)h0; (void)hout; (void)taildst; (void)bH; (void)bU; (void)bV; (void)bZ; (void)bX; (void)bG; (void)bY; (void)bDT; (void)bXC; (void)bXT; (void)bMG; (void)bACT; (void)bSSQ;

        for (int j = 0; j < nsub; ++j) { SUB_PARAMS(j) rmsnorm_rows_bf16(xin, rm, a.in[4], bH, R, gw, NGW, lane); }
        for (int i = blockIdx.x * 512 + tid; i < 2 * 16384; i += G * 512) VST[i] = 0.f;
        if (s == 0) { if (blockIdx.x == 0 && tid == 0) __hip_atomic_store(barctr, 0u, __ATOMIC_RELAXED, __HIP_MEMORY_SCOPE_AGENT);
                      grid.sync(); } else GBAR();
        for (int j = 0; j < nsub; ++j) { SUB_PARAMS(j)
          pg8::Gemm g{bH, WIN, R, NIN_PAD, 2048}; pg8::StaticOrder S; S.init(R, NIN_PAD, G, smp ? (int)((blockIdx.x + G - 64) % G) : (int)blockIdx.x);
          EpiInProj E{bU, bV, bZ, bX, bG, bDT, a.in[13], smp ? nullptr : VST};
          pg8::gemm_phase<EpiInProj, pg8::StaticOrder>(lds, g, S, E, nullptr); }
        GBAR();
        for (int j = 0; j < nsub; ++j) { SUB_PARAMS(j)
          if (smp) ln_rows(bV, a.in[6], a.in[7], a.out + O_VS, R, gw, NGW, lane);
          for (int i = blockIdx.x * 512 + tid; i < nb * 3 * CONVD; i += G * 512) { const int bb = i / (3 * CONVD), rem = i % (3 * CONVD), rr = rem / CONVD, cc = rem % CONVD;
              taildst[i] = bf2f(bX[(size_t)(bb * L + L - 3 + rr) * CONVD + cc]); }
          for (int i = blockIdx.x * 512 + tid; i < R; i += G * 512) { bSSQ[i] = 0.f; bSSQ[32768 + i] = 0.f; }
          bcconv_phase(lds, bX, bXC, bXT, hist, a.in[11], a.in[12], nb, L, G); }
        GBAR();
        for (int j = 0; j < nsub; ++j) { SUB_PARAMS(j) sgu_phase(lds, bU, bV, bU, a.in[8], a.in[9], smp ? 32 : 128, smp ? 16 : 128, G, smp ? nullptr : VST, a.in[6], a.in[7]); }
        for (int j = 0; j < nsub; ++j) { SUB_PARAMS(j) ssd_phase(lds, bX, bXC, bXT, bDT, bZ, bY, hist, h0, hout, a.in[11], a.in[12], a.in[14], a.in[15], nb, L, G); }
        GBAR();
        for (int st = 0; st < 2; ++st) {
          const bool normNow = ((st == 0) == (((blockIdx.x >> 3) & 1) == 0));
          if (normNow) { for (int j = 0; j < nsub; ++j) { SUB_PARAMS(j) gnorm_rows(bY, R, gw, NGW, lane); } }
          else { for (int j = 0; j < nsub; ++j) { SUB_PARAMS(j)
            pg8::Gemm g{bU, WA, R, 2048, 2048}; pg8::StaticOrder S; S.init(R, 2048, G, (int)blockIdx.x);
            EpiGate<false> E{bMG, bG, 0};
            pg8::gemm_phase<EpiGate<false>, pg8::StaticOrder>(lds, g, S, E, nullptr); } }
        }
        GBAR();
        for (int j = 0; j < nsub; ++j) { SUB_PARAMS(j)
          pg8::Gemm g{bY, WB, R, 2048, 4096}; pg8::StaticOrder S; S.init(R, 2048, G, (int)blockIdx.x);
          EpiGate<true> E{bMG, bG, 2048};
          pg8::gemm_phase<EpiGate<true>, pg8::StaticOrder>(lds, g, S, E, nullptr); }
        GBAR();
        for (int j = 0; j < nsub; ++j) { SUB_PARAMS(j)
          pg8::Gemm g{bMG, WO, R, 2048, 2048}; pg8::StaticOrder S; S.init(R, 2048, G, (int)blockIdx.x);
          EpiResidNorm E{xin, rm, bH, bSSQ};
          pg8::gemm_phase<EpiResidNorm, pg8::StaticOrder>(lds, g, S, E, nullptr); }
        GBAR();
        for (int j = 0; j < nsub; ++j) { SUB_PARAMS(j)
          pg8::Gemm g{bH, WUP, R, 2 * DFF, 2048}; pg8::StaticOrder S; S.init(R, 2 * DFF, G, (int)blockIdx.x);
          EpiSwiGLU E{bACT, bSSQ};
          pg8::gemm_phase<EpiSwiGLU, pg8::StaticOrder>(lds, g, S, E, nullptr); }
        GBAR();
        for (int j = 0; j < nsub; ++j) { SUB_PARAMS(j)
          pg8::Gemm g{bACT, WDN, R, 2048, DFF}; pg8::StaticOrder S; S.init(R, 2048, G, (int)blockIdx.x);
          EpiResidBf E{bH, bU, bSSQ + 32768};
          pg8::gemm_phase<EpiResidBf, pg8::StaticOrder>(lds, g, S, E, nullptr); }
        GBAR();
        for (int j = 0; j < nsub; ++j) { SUB_PARAMS(j) final_rows(bU, bSSQ + 32768, yout, rm, a.in[23], R, gw, NGW, lane); }
#undef SUB_PARAMS
    }
}

extern "C" void kernel_launch(void* const* d_in, const int* in_sizes, int n_in, void* d_out, int out_size, void* d_ws, size_t ws_size, hipStream_t stream) {
    static int grid_blocks = 0;
    if (!grid_blocks) {
        int dev = 0, cus = 0, per_cu = 0;
        hipGetDevice(&dev);
        hipDeviceGetAttribute(&cus, hipDeviceAttributeMultiprocessorCount, dev);
        hipFuncSetAttribute((const void*)fwd_kernel, hipFuncAttributeMaxDynamicSharedMemorySize, LDS_BYTES);
        hipOccupancyMaxActiveBlocksPerMultiprocessor(&per_cu, (const void*)fwd_kernel, 512, LDS_BYTES);
        if (per_cu < 1) per_cu = 1;
        grid_blocks = cus * per_cu;
        if (ws_size < WS_END || n_in != 24) fprintf(stderr, "kernel_launch: unexpected ws_size %zu (need %zu) or n_in %d\n", ws_size, (size_t)WS_END, n_in);
    }
    Args a{};
    for (int i = 0; i < 24; ++i) a.in[i] = (const float*)d_in[i];
    a.out = (float*)d_out; a.ws = (unsigned char*)d_ws;
    void* args[] = {&a};
    hipError_t e = hipLaunchCooperativeKernel((const void*)fwd_kernel, dim3(grid_blocks), dim3(512), args, LDS_BYTES, stream);
    if (e != hipSuccess) fprintf(stderr, "cooperative launch failed: %s (grid %d)\n", hipGetErrorString(e), grid_blocks);
}
```

```cpp
#include <hip/hip_runtime.h>
#include <hip/hip_cooperative_groups.h>
#include <cstdio>
namespace cg = cooperative_groups;
namespace pg8 {
#define PG8_LAS __attribute__((address_space(3)))
typedef unsigned short bf16_t;
typedef short bf16x8 __attribute__((ext_vector_type(8)));
typedef float f32x4 __attribute__((ext_vector_type(4)));
typedef unsigned u32x4 __attribute__((ext_vector_type(4)));
constexpr int BM = 256, BK = 64, HALF = 128, HTB = HALF * BK * 2  , STAGE_BYTES = 8 * HTB, NXCD = 8, WGM = 8;

__host__ __device__ __forceinline__ int lds_byte(int r, int c) { const int st = (r >> 4) * 2 + (c >> 5), rr = r & 15, cc = c & 31, ob = rr * 64 + cc * 2; return st * 1024 + (ob ^ (((ob >> 9) & 1) << 5)); }
__host__ __device__ __forceinline__ void stage_rc(int b, int& R, int& C) { const int st = b / 1024, sb = b % 1024, swz = sb ^ (((sb >> 9) & 1) << 5); R = (st >> 1) * 16 + swz / 64; C = (st & 1) * 32 + (swz % 64) / 2; }
__host__ __device__ __forceinline__ int perm32(int rho) { const int n = rho >> 4, i = rho & 15; return 8 * (i >> 2) + 4 * n + (i & 3); }

struct Unit { int pm, pn; };
struct Gemm { const bf16_t* A; const bf16_t* Bt; int M, N, K; };

struct StaticOrder {
    int nM, nN, nwg, G, c;
    __host__ __device__ void init(int M, int N, int G_, int c_) { nM = M / BM; nN = N / BM; nwg = nM * nN; G = G_; c = c_; }
    __host__ __device__ bool next(int i, Unit& u) const {
        const long L = (long)i * G + c; if (L >= nwg) return false;
        int wgid = (int)L; { const int q = nwg / NXCD, r = nwg % NXCD, xcd = wgid % NXCD, off = wgid / NXCD; wgid = (xcd < r ? xcd * (q + 1) : r * (q + 1) + (xcd - r) * q) + off; }
        const int nig = WGM * nN, gid = wgid / nig, fm = gid * WGM, gsz = (nM - fm) < WGM ? (nM - fm) : WGM;
        u.pm = fm + ((wgid % nig) % gsz); u.pn = (wgid % nig) / gsz; return true;
    }
    __device__ __forceinline__ void a_ready(const Unit&) const {}
    __device__ __forceinline__ void done(const Unit&) const {}
};
__device__ __forceinline__ unsigned cvt_pk_bf16(float lo, float hi) { unsigned r; asm volatile("v_cvt_pk_bf16_f32 %0, %1, %2" : "=v"(r) : "v"(lo), "v"(hi)); return r; }
template <class Epi, class Sched, bool STAMP = false>
__device__ __forceinline__ void gemm_phase(PG8_LAS unsigned char* lds, const Gemm g, const Sched& S, const Epi& E, unsigned long long* stamps) {
    int tid_l = threadIdx.x; asm volatile("" : "+v"(tid_l));
    const int tid = tid_l, wid = __builtin_amdgcn_readfirstlane(tid >> 6), lane = tid & 63, wr = wid >> 2, wc = wid & 3, fr = lane & 15, fq = lane >> 4;
    const int K = g.K, nt = K / BK;
    int ts_lo = 0, ts_hi = 0, nts = 0; const unsigned long long rt_entry = STAMP ? (unsigned long long)wall_clock64() : 0ull;
#define PG8_STAMP() do { if (STAMP && wid == 0 && nts < 64) { const unsigned long long _c = (unsigned long long)clock64(); \
        ts_lo = (lane == nts) ? (int)(unsigned)_c : ts_lo; ts_hi = (lane == nts) ? (int)(unsigned)(_c >> 32) : ts_hi; ++nts; } } while (0)
    PG8_STAMP();
    unsigned voffA[2], voffB[2];
#pragma unroll
    for (int i = 0; i < 2; ++i) { int R, C; stage_rc(tid * 16 + i * 8192, R, C); const int Rb = Epi::PERM ? ((R & ~31) + perm32(R & 31)) : R;
        voffA[i] = (unsigned)(R * K + C) * 2u; voffB[i] = (unsigned)(Rb * K + C) * 2u; }
    const size_t kstep = (size_t)(BK * 2);
    const size_t hstep = (size_t)HALF * K * 2;
    const size_t tstep = 2 * hstep;
    const unsigned ldsw = (unsigned)wid * 1024u;
    const int aoff = lds_byte(wr * 64 + fr, fq * 8), boff = lds_byte(wc * 32 + fr, fq * 8);
#define PG8_SA(b, h) (((b) * 2 + (h)) * HTB)
#define PG8_SB(b, h) ((4 + (b) * 2 + (h)) * HTB)
#define PG8_STAGE(bufoff, gbase, voff) do { _Pragma("unroll") for (int _i = 0; _i < 2; ++_i) \
        __builtin_amdgcn_global_load_lds((const unsigned*)((const char*)(gbase) + (voff)[_i]), (PG8_LAS unsigned*)(lds + (bufoff) + ldsw + _i * 8192), 16, 0, 0); } while (0)
#define PG8_LDA(dst, b, h) do { _Pragma("unroll") for (int m = 0; m < 4; ++m) _Pragma("unroll") for (int k = 0; k < 2; ++k) dst[m][k] = *(const PG8_LAS bf16x8*)(lds + PG8_SA(b, h) + aoff + m * 2048 + k * 1024); } while (0)
#define PG8_LDB(dst, b, h) do { _Pragma("unroll") for (int n = 0; n < 2; ++n) _Pragma("unroll") for (int k = 0; k < 2; ++k) dst[n][k] = *(const PG8_LAS bf16x8*)(lds + PG8_SB(b, h) + boff + n * 2048 + k * 1024); } while (0)
#define PG8_MMA(ai, bj, At, Bt) do { __builtin_amdgcn_s_setprio(1); _Pragma("unroll") for (int m = 0; m < 4; ++m) _Pragma("unroll") for (int n = 0; n < 2; ++n) _Pragma("unroll") for (int k = 0; k < 2; ++k) \
        acc[ai][bj][m][n] = __builtin_amdgcn_mfma_f32_16x16x32_bf16(Bt[n][k], At[m][k], acc[ai][bj][m][n], 0, 0, 0); __builtin_amdgcn_s_setprio(0); } while (0)
#define PG8_WAIT_V(n) asm volatile("s_waitcnt vmcnt(" #n ")" ::: "memory")
#define PG8_WAIT_L(n) asm volatile("s_waitcnt lgkmcnt(" #n ")" ::: "memory")
#define PG8_BAR __builtin_amdgcn_s_barrier()
#define PG8_SCHED __builtin_amdgcn_sched_barrier(0)
    Unit cur, nxt; int ui = 0;
    if (!S.next(0, cur)) return;
    f32x4 acc[2][2][4][2];
#pragma unroll
    for (int a = 0; a < 2; ++a)
#pragma unroll
        for (int b = 0; b < 2; ++b)
#pragma unroll
            for (int m = 0; m < 4; ++m)
#pragma unroll
                for (int n = 0; n < 2; ++n) acc[a][b][m][n] = (f32x4){0.f, 0.f, 0.f, 0.f};
    bf16x8 At[4][2], B0[2][2], B1[2][2];
    const char* cA = (const char*)g.A + (size_t)cur.pm * tstep; const char* cB = (const char*)g.Bt + (size_t)cur.pn * tstep;
    S.a_ready(cur);
    PG8_STAGE(PG8_SB(0, 0), cB, voffB); PG8_STAGE(PG8_SA(0, 0), cA, voffA); PG8_STAGE(PG8_SB(0, 1), cB + hstep, voffB); PG8_STAGE(PG8_SA(0, 1), cA + hstep, voffA);
    if (wr == 1) PG8_BAR;
    PG8_WAIT_V(4); PG8_BAR;
    PG8_STAGE(PG8_SB(1, 0), cB + kstep, voffB); PG8_STAGE(PG8_SA(1, 0), cA + kstep, voffA); PG8_STAGE(PG8_SB(1, 1), cB + hstep + kstep, voffB);
    PG8_WAIT_V(6); PG8_BAR;
    PG8_STAMP();
    for (;;) {
        const bool has_next = S.next(ui + 1, nxt);
        const char* nA = has_next ? (const char*)g.A + (size_t)nxt.pm * tstep : cA; const char* nB = has_next ? (const char*)g.Bt + (size_t)nxt.pn * tstep : cB;
        for (int t = 0; t < nt; t += 2) {
            const bool last = (t == nt - 2);
            const char* a1 = cA + (size_t)(t + 1) * kstep;
            const char* a2 = last ? nA : cA + (size_t)(t + 2) * kstep; const char* b2 = last ? nB : cB + (size_t)(t + 2) * kstep;
            const char* a3 = a2 + kstep; const char* b3 = b2 + kstep;
            if (last && has_next) S.a_ready(nxt);
            PG8_LDB(B0, 0, 0); PG8_SCHED; PG8_LDA(At, 0, 0); PG8_STAGE(PG8_SA(1, 1), a1 + hstep, voffA);
            PG8_WAIT_L(8); PG8_BAR; PG8_WAIT_L(0); PG8_MMA(0, 0, At, B0); PG8_BAR; PG8_SCHED;
            PG8_LDB(B1, 0, 1); PG8_STAGE(PG8_SB(0, 0), b2, voffB);
            PG8_BAR; PG8_WAIT_L(0); PG8_MMA(0, 1, At, B1); PG8_BAR;
            PG8_LDA(At, 0, 1); PG8_STAGE(PG8_SA(0, 0), a2, voffA);
            PG8_BAR; PG8_WAIT_L(0); PG8_MMA(1, 0, At, B0); PG8_BAR; PG8_SCHED;
            PG8_STAGE(PG8_SB(0, 1), b2 + hstep, voffB);
            PG8_WAIT_V(6); PG8_BAR; PG8_MMA(1, 1, At, B1); PG8_BAR;
            PG8_LDB(B0, 1, 0); PG8_SCHED; PG8_LDA(At, 1, 0); PG8_STAGE(PG8_SA(0, 1), a2 + hstep, voffA);
            PG8_WAIT_L(8); PG8_BAR; PG8_WAIT_L(0); PG8_MMA(0, 0, At, B0); PG8_BAR; PG8_SCHED;
            PG8_LDB(B1, 1, 1); PG8_STAGE(PG8_SB(1, 0), b3, voffB);
            PG8_BAR; PG8_WAIT_L(0); PG8_MMA(0, 1, At, B1); PG8_BAR;
            PG8_LDA(At, 1, 1); PG8_STAGE(PG8_SA(1, 0), a3, voffA);
            PG8_BAR; PG8_WAIT_L(0); PG8_MMA(1, 0, At, B0); PG8_BAR; PG8_SCHED;
            PG8_STAGE(PG8_SB(1, 1), b3 + hstep, voffB);
            PG8_WAIT_V(6); PG8_BAR; PG8_MMA(1, 1, At, B1); PG8_BAR;
        }
        PG8_STAMP();
        if constexpr (!Epi::AFTER_DRAIN) { E(acc, cur, wr, wc, fr, fq); S.done(cur); }
        PG8_STAMP();
        if (!has_next) break;
#pragma unroll
        for (int a = 0; a < 2; ++a)
#pragma unroll
            for (int b = 0; b < 2; ++b)
#pragma unroll
                for (int m = 0; m < 4; ++m)
#pragma unroll
                    for (int n = 0; n < 2; ++n) acc[a][b][m][n] = (f32x4){0.f, 0.f, 0.f, 0.f};
        cur = nxt; cA = nA; cB = nB; ++ui;
    }
    PG8_WAIT_V(0);
    if (wr == 0) PG8_BAR;
    PG8_BAR;
    if constexpr (Epi::AFTER_DRAIN) { E.fused(acc, cur, wr, wc, fr, fq, lds, wid, lane); S.done(cur); }
    PG8_STAMP();
    if (STAMP && wid == 0) { stamps[lane] = lane < nts ? (((unsigned long long)(unsigned)ts_hi << 32) | (unsigned)ts_lo) : 0ull;
        if (lane == 62) stamps[62] = rt_entry; if (lane == 63) stamps[63] = (unsigned long long)wall_clock64(); }
#undef PG8_STAMP
#undef PG8_SA
#undef PG8_SB
#undef PG8_STAGE
#undef PG8_LDA
#undef PG8_LDB
#undef PG8_MMA
#undef PG8_WAIT_V
#undef PG8_WAIT_L
#undef PG8_BAR
#undef PG8_SCHED
}
}

using pg8::bf16_t; using pg8::bf16x8; using pg8::f32x4; using pg8::u32x4;
typedef unsigned u32x2 __attribute__((ext_vector_type(2)));
#define LAS __attribute__((address_space(3)))

constexpr int DM = 2048, DSSM = 4096, CONVD = 6144, NHEAD = 64, DFF = 5632, NIN_PAD = 18688;
constexpr float EPSN = 1e-6f;
constexpr size_t MiB = (size_t)1 << 20;
constexpr size_t WS_WIN = 0, WS_WA = 73 * MiB, WS_WB = 81 * MiB, WS_WO = 97 * MiB, WS_WUP = 105 * MiB, WS_WDN = 149 * MiB;
constexpr size_t WS_H = 171 * MiB, WS_U = 235 * MiB, WS_V = 299 * MiB, WS_Z = 363 * MiB, WS_XBC = 491 * MiB, WS_G = 683 * MiB, WS_Y = 811 * MiB, WS_DT = 939 * MiB, WS_TAIL = 943 * MiB, WS_SSQ = 943 * MiB + 512 * 1024, WS_BAR = 943 * MiB + 768 * 1024, WS_VST = 943 * MiB + 832 * 1024, WS_XBT = 944 * MiB, WS_SMP = 976 * MiB, WS_END = 1015 * MiB;
constexpr size_t WS_MG = WS_XBC, WS_ACT = WS_XBC;
constexpr size_t O_YP = 0, O_YS = 67108864, O_SSMP = 68157440, O_CONVP = 70254592, O_SSMS = 70328320, O_CONVS = 87105536, O_VS = 87695360;
constexpr int LDS_BYTES = 131072;

__device__ __forceinline__ float bflo(unsigned w) { return __uint_as_float(w << 16); }
__device__ __forceinline__ float bfhi(unsigned w) { return __uint_as_float(w & 0xffff0000u); }
__device__ __forceinline__ float bf2f(bf16_t b) { return __uint_as_float(((unsigned)b) << 16); }
typedef __bf16 bf16x2_t __attribute__((ext_vector_type(2)));
typedef float f32x2c __attribute__((ext_vector_type(2)));
__device__ __forceinline__ unsigned pk2(float lo, float hi) { const f32x2c v = (f32x2c){lo, hi}; const bf16x2_t b = __builtin_convertvector(v, bf16x2_t); return __builtin_bit_cast(unsigned, b); }
__device__ __forceinline__ bf16_t f2bf(float f) { return (bf16_t)(pk2(f, 0.f) & 0xffffu); }
__device__ __forceinline__ float sigm(float a) { return __builtin_amdgcn_rcpf(1.0f + __expf(-a)); }
__device__ __forceinline__ float wave_sum(float v) {
#pragma unroll
    for (int o = 1; o < 64; o <<= 1) v += __shfl_xor(v, o);
    return v;
}
struct RowMap { int Ls, Lfull, toff;
    __device__ __forceinline__ size_t operator()(int r) const { return (size_t)(r >> Ls) * Lfull + toff + (r & ((1 << Ls) - 1)); } };

typedef float f32x2 __attribute__((ext_vector_type(2)));
__device__ __forceinline__ f32x2 exp2_2(f32x2 a) { f32x2 r; r.x = __builtin_amdgcn_exp2f(a.x); r.y = __builtin_amdgcn_exp2f(a.y); return r; }
__device__ __forceinline__ f32x2 rcp_2(f32x2 a) { f32x2 r; r.x = __builtin_amdgcn_rcpf(a.x); r.y = __builtin_amdgcn_rcpf(a.y); return r; }
__device__ __forceinline__ f32x2 sigm_2(f32x2 x) { return rcp_2(exp2_2(x * -1.4426950409f) + 1.0f); }
__device__ __forceinline__ f32x2 silu_2(f32x2 x) { return x * sigm_2(x); }
__device__ __forceinline__ f32x2 gelu_2(f32x2 x) { const f32x2 t = (x * x) * -0.10294324f + -2.3022082f; return x * rcp_2(exp2_2(x * t) + 1.0f); }
template <int KIND> __device__ __forceinline__ unsigned act_pk(float a, float b) {
    f32x2 v = (f32x2){a, b};
    if (KIND == 0) v = gelu_2(v); else if (KIND == 1) v = silu_2(v); else if (KIND == 3) v = sigm_2(v);
    return pk2(v.x, v.y);
}
template <int KIND> __device__ __forceinline__ void inproj_tile(const f32x4 (&acc)[2][2][4][2], bf16_t* base, int ldc, int row0, int col0) {
#pragma unroll
    for (int ai = 0; ai < 2; ++ai)
#pragma unroll
        for (int m = 0; m < 4; ++m) {
            bf16_t* rowp = base + (size_t)(row0 + ai * 128 + m * 16) * ldc + col0;
#pragma unroll
            for (int bj = 0; bj < 2; ++bj) {
                const f32x4 v0 = acc[ai][bj][m][0], v1 = acc[ai][bj][m][1];
                u32x4 w; w.x = act_pk<KIND>(v0[0], v0[1]); w.y = act_pk<KIND>(v0[2], v0[3]); w.z = act_pk<KIND>(v1[0], v1[1]); w.w = act_pk<KIND>(v1[2], v1[3]);
                *(u32x4*)(rowp + bj * 128) = w;
            }
        }
}
__device__ __forceinline__ void inproj_tile_vstats(const f32x4 (&acc)[2][2][4][2], bf16_t* base, int row0, int col0, float* vst, int fq) {
#pragma unroll
    for (int ai = 0; ai < 2; ++ai)
#pragma unroll
        for (int m = 0; m < 4; ++m) {
            const int r = row0 + ai * 128 + m * 16;
            bf16_t* rowp = base + (size_t)r * 2048 + col0;
            f32x2 s1 = (f32x2){0.f, 0.f}, s2 = (f32x2){0.f, 0.f};
#pragma unroll
            for (int bj = 0; bj < 2; ++bj) {
                const f32x4 v0 = acc[ai][bj][m][0], v1 = acc[ai][bj][m][1];
                const f32x2 a = gelu_2((f32x2){v0[0], v0[1]}), b = gelu_2((f32x2){v0[2], v0[3]}), c = gelu_2((f32x2){v1[0], v1[1]}), d = gelu_2((f32x2){v1[2], v1[3]});
                s1 += (a + b) + (c + d); s2 += (a * a + b * b) + (c * c + d * d);
                u32x4 w; w.x = pk2(a.x, a.y); w.y = pk2(b.x, b.y); w.z = pk2(c.x, c.y); w.w = pk2(d.x, d.y);
                *(u32x4*)(rowp + bj * 128) = w;
            }
            float t1 = s1.x + s1.y, t2 = s2.x + s2.y;
            t1 += __shfl_xor(t1, 16); t1 += __shfl_xor(t1, 32); t2 += __shfl_xor(t2, 16); t2 += __shfl_xor(t2, 32);
            if (fq == 0) { atomicAdd(vst + 2 * r, t1); atomicAdd(vst + 2 * r + 1, t2); }
        }
}
__device__ __forceinline__ float act_k(float x, int kind) {
    const float a = (kind == 0) ? 1.5957691216f * (x + 0.044715f * x * x * x) : x;
    const float s = sigm(a);
    return kind == 3 ? s : (kind == 2 ? x : x * s);
}
struct EpiInProj {
    static constexpr bool PERM = true, AFTER_DRAIN = false;
    bf16_t *U, *V, *Z, *XBC, *G; float* DT; const float* dt_bias; float* vst;
    __device__ __forceinline__ void operator()(const f32x4 (&acc)[2][2][4][2], const pg8::Unit& u, int wr, int wc, int fr, int fq) const {
        const int pn = u.pn; const int row0 = u.pm * 256 + wr * 64 + fr;
        if (pn == 72) {
            if (wc < 2) {
                const int cl = wc * 32 + 8 * fq;
                const f32x4 b0 = *(const f32x4*)(dt_bias + cl), b1 = *(const f32x4*)(dt_bias + cl + 4);
#pragma unroll
                for (int ai = 0; ai < 2; ++ai)
#pragma unroll
                    for (int m = 0; m < 4; ++m) {
                        float* rp = DT + (size_t)(row0 + ai * 128 + m * 16) * 64 + cl;
                        f32x4 v0 = acc[ai][0][m][0] + b0, v1 = acc[ai][0][m][1] + b1;
#pragma unroll
                        for (int j = 0; j < 4; ++j) { v0[j] = fmaxf(v0[j], 0.f) + log1pf(__expf(-fabsf(v0[j]))); v1[j] = fmaxf(v1[j], 0.f) + log1pf(__expf(-fabsf(v1[j]))); }
                        *(f32x4*)rp = v0; *(f32x4*)(rp + 4) = v1;
                    }
            }
            return;
        }
        int kind, ldc, colt; bf16_t* base;
        if (pn < 8) { kind = 0; base = U; ldc = 2048; colt = pn * 256; }
        else if (pn < 16) { kind = 0; base = V; ldc = 2048; colt = (pn - 8) * 256; }
        else if (pn < 32) { kind = 1; base = Z; ldc = 4096; colt = (pn - 16) * 256; }
        else if (pn < 56) { kind = 2; base = XBC; ldc = 6144; colt = (pn - 32) * 256; }
        else { kind = 3; base = G; ldc = 4096; colt = (pn - 56) * 256; }
        const int col0 = colt + wc * 32 + 8 * fq;
        if (pn >= 8 && pn < 16 && vst) inproj_tile_vstats(acc, base, row0, col0, vst, fq);
        else if (kind == 0) inproj_tile<0>(acc, base, ldc, row0, col0);
        else if (kind == 1) inproj_tile<1>(acc, base, ldc, row0, col0);
        else if (kind == 2) inproj_tile<2>(acc, base, ldc, row0, col0);
        else inproj_tile<3>(acc, base, ldc, row0, col0);
    }
};
struct EpiNull {
    static constexpr bool PERM = true, AFTER_DRAIN = false;
    float* sink;
    __device__ __forceinline__ void operator()(const f32x4 (&acc)[2][2][4][2], const pg8::Unit& u, int wr, int wc, int fr, int fq) const {
        float s = 0.f;
#pragma unroll
        for (int ai = 0; ai < 2; ++ai)
#pragma unroll
            for (int bj = 0; bj < 2; ++bj)
#pragma unroll
                for (int m = 0; m < 4; ++m)
#pragma unroll
                    for (int n = 0; n < 2; ++n) s += (acc[ai][bj][m][n][0] + acc[ai][bj][m][n][1]) + (acc[ai][bj][m][n][2] + acc[ai][bj][m][n][3]);
        sink[(size_t)(u.pm * 73 + u.pn) * 512 + threadIdx.x] = s;
    }
};
template <bool ACCUM> struct EpiGate {
    static constexpr bool PERM = true, AFTER_DRAIN = false;
    bf16_t* MG; const bf16_t* Gt; int goff;
    __device__ __forceinline__ void operator()(const f32x4 (&acc)[2][2][4][2], const pg8::Unit& u, int wr, int wc, int fr, int fq) const {
        const int row0 = u.pm * 256 + wr * 64 + fr, col0 = u.pn * 256 + wc * 32 + 8 * fq;
#pragma unroll
        for (int ai = 0; ai < 2; ++ai)
#pragma unroll
            for (int m = 0; m < 4; ++m) {
                const size_t r = (size_t)(row0 + ai * 128 + m * 16);
#pragma unroll
                for (int bj = 0; bj < 2; ++bj) {
                    const int c = col0 + bj * 128;
                    const u32x4 gw = *(const u32x4*)(Gt + r * 4096 + goff + c);
                    const f32x4 v0 = acc[ai][bj][m][0], v1 = acc[ai][bj][m][1];
                    float o0 = bflo(gw.x) * v0[0], o1 = bfhi(gw.x) * v0[1], o2 = bflo(gw.y) * v0[2], o3 = bfhi(gw.y) * v0[3];
                    float o4 = bflo(gw.z) * v1[0], o5 = bfhi(gw.z) * v1[1], o6 = bflo(gw.w) * v1[2], o7 = bfhi(gw.w) * v1[3];
                    bf16_t* dst = MG + r * 2048 + c;
                    if (ACCUM) { const u32x4 pw = *(const u32x4*)dst;
                        o0 += bflo(pw.x); o1 += bfhi(pw.x); o2 += bflo(pw.y); o3 += bfhi(pw.y); o4 += bflo(pw.z); o5 += bfhi(pw.z); o6 += bflo(pw.w); o7 += bfhi(pw.w); }
                    u32x4 w; w.x = pk2(o0, o1); w.y = pk2(o2, o3); w.z = pk2(o4, o5); w.w = pk2(o6, o7);
                    *(u32x4*)dst = w;
                }
            }
    }
};
struct EpiSwiGLU {
    static constexpr bool PERM = true, AFTER_DRAIN = false;
    bf16_t* ACT; const float* SSQ;
    __device__ __forceinline__ void operator()(const f32x4 (&acc)[2][2][4][2], const pg8::Unit& u, int wr, int wc, int fr, int fq) const {
        const int row0 = u.pm * 256 + wr * 64 + fr, j0 = u.pn * 128 + wc * 16 + 4 * fq;
#pragma unroll
        for (int ai = 0; ai < 2; ++ai)
#pragma unroll
            for (int m = 0; m < 4; ++m) {
                bf16_t* rowp = ACT + (size_t)(row0 + ai * 128 + m * 16) * DFF + j0;
                const float rs = rsqrtf(SSQ[row0 + ai * 128 + m * 16] * (1.f / 2048.f) + EPSN);
#pragma unroll
                for (int bj = 0; bj < 2; ++bj) {
                    const f32x4 g = acc[ai][bj][m][0] * rs, up = acc[ai][bj][m][1] * rs;
                    const f32x2 o0 = silu_2((f32x2){g[0], g[1]}) * (f32x2){up[0], up[1]}, o1 = silu_2((f32x2){g[2], g[3]}) * (f32x2){up[2], up[3]};
                    u32x2 w; w.x = pk2(o0.x, o0.y); w.y = pk2(o1.x, o1.y);
                    *(u32x2*)(rowp + bj * 64) = w;
                }
            }
    }
};
struct EpiResid {
    static constexpr bool PERM = false, AFTER_DRAIN = false;
    const float* base; float* out; RowMap rm;
    __device__ __forceinline__ void operator()(const f32x4 (&acc)[2][2][4][2], const pg8::Unit& u, int wr, int wc, int fr, int fq) const {
        const int row0 = u.pm * 256 + wr * 64 + fr, col0 = u.pn * 256 + wc * 32 + 4 * fq;
#pragma unroll
        for (int ai = 0; ai < 2; ++ai)
#pragma unroll
            for (int m = 0; m < 4; ++m) {
                const size_t off = rm(row0 + ai * 128 + m * 16) * 2048 + col0;
#pragma unroll
                for (int bj = 0; bj < 2; ++bj)
#pragma unroll
                    for (int n = 0; n < 2; ++n) {
                        const f32x4 b = *(const f32x4*)(base + off + bj * 128 + n * 16);
                        *(f32x4*)(out + off + bj * 128 + n * 16) = b + acc[ai][bj][m][n];
                    }
            }
    }
};

struct EpiResidNorm {
    static constexpr bool PERM = true, AFTER_DRAIN = false;
    const float* base; RowMap rm; bf16_t* X1; float* SSQ;
    __device__ __forceinline__ void operator()(const f32x4 (&acc)[2][2][4][2], const pg8::Unit& u, int wr, int wc, int fr, int fq) const {
        const int row0 = u.pm * 256 + wr * 64 + fr, col0 = u.pn * 256 + wc * 32 + 8 * fq;
#pragma unroll
        for (int ai = 0; ai < 2; ++ai)
#pragma unroll
            for (int m = 0; m < 4; ++m) {
                const int r = row0 + ai * 128 + m * 16;
                const size_t off = rm(r) * 2048 + col0;
                float ss = 0.f;
#pragma unroll
                for (int bj = 0; bj < 2; ++bj) {
                    const f32x4 b0 = *(const f32x4*)(base + off + bj * 128), b1 = *(const f32x4*)(base + off + bj * 128 + 4);
                    const f32x4 x0 = b0 + acc[ai][bj][m][0], x1 = b1 + acc[ai][bj][m][1];
                    ss += ((x0[0] * x0[0] + x0[1] * x0[1]) + (x0[2] * x0[2] + x0[3] * x0[3])) + ((x1[0] * x1[0] + x1[1] * x1[1]) + (x1[2] * x1[2] + x1[3] * x1[3]));
                    u32x4 w; w.x = pk2(x0[0], x0[1]); w.y = pk2(x0[2], x0[3]); w.z = pk2(x1[0], x1[1]); w.w = pk2(x1[2], x1[3]);
                    *(u32x4*)(X1 + (size_t)r * 2048 + col0 + bj * 128) = w;
                }
                ss += __shfl_xor(ss, 16); ss += __shfl_xor(ss, 32);
                if (fq == 0) atomicAdd(SSQ + r, ss);
            }
    }
};
struct EpiResidBf {
    static constexpr bool PERM = true, AFTER_DRAIN = false;
    const bf16_t* X1; bf16_t* X2; float* SSQ2;
    __device__ __forceinline__ void operator()(const f32x4 (&acc)[2][2][4][2], const pg8::Unit& u, int wr, int wc, int fr, int fq) const {
        const int row0 = u.pm * 256 + wr * 64 + fr, col0 = u.pn * 256 + wc * 32 + 8 * fq;
#pragma unroll
        for (int ai = 0; ai < 2; ++ai)
#pragma unroll
            for (int m = 0; m < 4; ++m) {
                const int r = row0 + ai * 128 + m * 16;
                float ss = 0.f;
#pragma unroll
                for (int bj = 0; bj < 2; ++bj) {
                    const size_t eo = (size_t)r * 2048 + col0 + bj * 128;
                    const u32x4 xw = *(const u32x4*)(X1 + eo);
                    const f32x4 a0 = acc[ai][bj][m][0], a1 = acc[ai][bj][m][1];
                    const float y0 = bflo(xw.x) + a0[0], y1 = bfhi(xw.x) + a0[1], y2 = bflo(xw.y) + a0[2], y3 = bfhi(xw.y) + a0[3];
                    const float y4 = bflo(xw.z) + a1[0], y5 = bfhi(xw.z) + a1[1], y6 = bflo(xw.w) + a1[2], y7 = bfhi(xw.w) + a1[3];
                    ss += ((y0 * y0 + y1 * y1) + (y2 * y2 + y3 * y3)) + ((y4 * y4 + y5 * y5) + (y6 * y6 + y7 * y7));
                    u32x4 w; w.x = pk2(y0, y1); w.y = pk2(y2, y3); w.z = pk2(y4, y5); w.w = pk2(y6, y7);
                    *(u32x4*)(X2 + eo) = w;
                }
                ss += __shfl_xor(ss, 16); ss += __shfl_xor(ss, 32);
                if (fq == 0) atomicAdd(SSQ2 + r, ss);
            }
    }
};
__device__ __forceinline__ void final_rows(const bf16_t* X2, const float* SSQ2, float* out, RowMap rm, const float* g, int R, int gw, int NGW, int lane) {
    asm volatile("" : "+v"(lane)); asm volatile("" : "+s"(gw));
    for (int r = gw; r < R; r += NGW) {
        const float rstd = rsqrtf(SSQ2[r] * (1.f / 2048.f) + EPSN);
        const u32x4* xr = (const u32x4*)(X2 + (size_t)r * 2048) + lane;
        float* o = out + rm(r) * 2048;
#pragma unroll
        for (int j = 0; j < 4; ++j) { const u32x4 w = xr[64 * j]; const int c = (lane + 64 * j) * 8;
            const f32x4 g0 = *(const f32x4*)(g + c), g1 = *(const f32x4*)(g + c + 4);
            *(f32x4*)(o + c) = (f32x4){bflo(w.x) * rstd * g0[0], bfhi(w.x) * rstd * g0[1], bflo(w.y) * rstd * g0[2], bfhi(w.y) * rstd * g0[3]};
            *(f32x4*)(o + c + 4) = (f32x4){bflo(w.z) * rstd * g1[0], bfhi(w.z) * rstd * g1[1], bflo(w.w) * rstd * g1[2], bfhi(w.w) * rstd * g1[3]}; }
    }
}

__device__ __forceinline__ void gbar(unsigned* ctr, unsigned& target, unsigned G) {
    asm volatile("s_waitcnt vmcnt(0)" ::: "memory");
    __syncthreads();
    if (threadIdx.x == 0) {
        target += G;
        __builtin_amdgcn_fence(__ATOMIC_RELEASE, "agent");
        asm volatile("s_waitcnt vmcnt(0)" ::: "memory");
        __hip_atomic_fetch_add(ctr, 1u, __ATOMIC_RELAXED, __HIP_MEMORY_SCOPE_AGENT);
        while (__hip_atomic_load(ctr, __ATOMIC_RELAXED, __HIP_MEMORY_SCOPE_AGENT) < target) { }
        __builtin_amdgcn_fence(__ATOMIC_ACQUIRE, "agent");
        asm volatile("s_waitcnt vmcnt(0)" ::: "memory");
    }
    __syncthreads();
}

__device__ __forceinline__ void rmsnorm_rows_bf16(const float* src, RowMap rm, const float* g, bf16_t* dst, int R, int gw, int NGW, int lane) {
    asm volatile("" : "+v"(lane)); asm volatile("" : "+s"(gw));
    for (int r = gw; r < R; r += NGW) {
        const f32x4* xr = (const f32x4*)(src + rm(r) * 2048) + lane;
        f32x4 v[8]; float ss = 0.f;
#pragma unroll
        for (int j = 0; j < 8; ++j) { v[j] = xr[64 * j]; ss += (v[j].x * v[j].x + v[j].y * v[j].y) + (v[j].z * v[j].z + v[j].w * v[j].w); }
        const float rstd = rsqrtf(wave_sum(ss) * (1.f / 2048.f) + EPSN);
        u32x2* o = (u32x2*)(dst + (size_t)r * 2048) + lane;
#pragma unroll
        for (int j = 0; j < 8; ++j) { const f32x4 gg = ((const f32x4*)g)[lane + 64 * j];
            u32x2 w; w.x = pk2(v[j].x * rstd * gg.x, v[j].y * rstd * gg.y); w.y = pk2(v[j].z * rstd * gg.z, v[j].w * rstd * gg.w); o[64 * j] = w; }
    }
}
__device__ __forceinline__ void rmsnorm_rows_inplace(float* buf, RowMap rm, const float* g, int R, int gw, int NGW, int lane) {
    asm volatile("" : "+v"(lane)); asm volatile("" : "+s"(gw));
    for (int r = gw; r < R; r += NGW) {
        f32x4* xr = (f32x4*)(buf + rm(r) * 2048) + lane;
        f32x4 v[8]; float ss = 0.f;
#pragma unroll
        for (int j = 0; j < 8; ++j) { v[j] = xr[64 * j]; ss += (v[j].x * v[j].x + v[j].y * v[j].y) + (v[j].z * v[j].z + v[j].w * v[j].w); }
        const float rstd = rsqrtf(wave_sum(ss) * (1.f / 2048.f) + EPSN);
#pragma unroll
        for (int j = 0; j < 8; ++j) { const f32x4 gg = ((const f32x4*)g)[lane + 64 * j]; xr[64 * j] = v[j] * rstd * gg; }
    }
}
__device__ __forceinline__ void ln_rows(bf16_t* V, const float* lg, const float* lb, float* vout, int R, int gw, int NGW, int lane) {
    asm volatile("" : "+v"(lane)); asm volatile("" : "+s"(gw));
    for (int r = gw; r < R; r += NGW) {
        u32x4* vr = (u32x4*)(V + (size_t)r * 2048) + lane;
        float x[4][8]; float s = 0.f;
#pragma unroll
        for (int j = 0; j < 4; ++j) { const u32x4 w = vr[64 * j];
            x[j][0] = bflo(w.x); x[j][1] = bfhi(w.x); x[j][2] = bflo(w.y); x[j][3] = bfhi(w.y); x[j][4] = bflo(w.z); x[j][5] = bfhi(w.z); x[j][6] = bflo(w.w); x[j][7] = bfhi(w.w);
#pragma unroll
            for (int k = 0; k < 8; ++k) s += x[j][k]; }
        const float mu = wave_sum(s) * (1.f / 2048.f); float q = 0.f;
#pragma unroll
        for (int j = 0; j < 4; ++j)
#pragma unroll
            for (int k = 0; k < 8; ++k) { x[j][k] -= mu; q += x[j][k] * x[j][k]; }
        const float rstd = rsqrtf(wave_sum(q) * (1.f / 2048.f) + EPSN);
#pragma unroll
        for (int j = 0; j < 4; ++j) { const int c = (lane + 64 * j) * 8;
            const f32x4 g0 = *(const f32x4*)(lg + c), g1 = *(const f32x4*)(lg + c + 4), b0 = *(const f32x4*)(lb + c), b1 = *(const f32x4*)(lb + c + 4);
            f32x4 y0, y1;
            y0.x = x[j][0] * rstd * g0.x + b0.x; y0.y = x[j][1] * rstd * g0.y + b0.y; y0.z = x[j][2] * rstd * g0.z + b0.z; y0.w = x[j][3] * rstd * g0.w + b0.w;
            y1.x = x[j][4] * rstd * g1.x + b1.x; y1.y = x[j][5] * rstd * g1.y + b1.y; y1.z = x[j][6] * rstd * g1.z + b1.z; y1.w = x[j][7] * rstd * g1.w + b1.w;
            u32x4 w; w.x = pk2(y0.x, y0.y); w.y = pk2(y0.z, y0.w); w.z = pk2(y1.x, y1.y); w.w = pk2(y1.z, y1.w); vr[64 * j] = w;
            if (vout) { float* o = vout + (size_t)r * 2048 + c; *(f32x4*)o = y0; *(f32x4*)(o + 4) = y1; } }
    }
}
__device__ __forceinline__ void gnorm_rows(bf16_t* Y, int R, int gw, int NGW, int lane) {
    asm volatile("" : "+v"(lane)); asm volatile("" : "+s"(gw));
    for (int r = gw; r < R; r += NGW) {
        u32x4* yr = (u32x4*)(Y + (size_t)r * 4096) + lane;
#pragma unroll
        for (int j = 0; j < 8; ++j) { const u32x4 w = yr[64 * j];
            float x0 = bflo(w.x), x1 = bfhi(w.x), x2 = bflo(w.y), x3 = bfhi(w.y), x4 = bflo(w.z), x5 = bfhi(w.z), x6 = bflo(w.w), x7 = bfhi(w.w);
            const float ss = (x0 * x0 + x1 * x1) + (x2 * x2 + x3 * x3) + (x4 * x4 + x5 * x5) + (x6 * x6 + x7 * x7);
            const float rstd = rsqrtf(wave_sum(ss) * (1.f / 512.f) + EPSN);
            u32x4 o; o.x = pk2(x0 * rstd, x1 * rstd); o.y = pk2(x2 * rstd, x3 * rstd); o.z = pk2(x4 * rstd, x5 * rstd); o.w = pk2(x6 * rstd, x7 * rstd); yr[64 * j] = o; }
    }
}

__device__ __forceinline__ int wt_rowmap(int mode, int n) {
    if (mode == 1) return n < 14336 ? n : (n < 14400 ? 18432 + (n - 14336) : n - 64);
    if (mode == 2) return 8 * (n >> 2) + (n & 3);
    if (mode == 3) return 8 * (n >> 2) + 4 + (n & 3);
    return n;
}
__device__ __forceinline__ void transpose_item(const float* W, int K, int N, bf16_t* WT, LAS bf16_t* scr, int item, int lane, int mode, const float* kscale) {
    const int nblk = N / 64, kb = item / nblk, nb = item % nblk, k0 = 64 * kb, n0 = 64 * nb;
    const int nl = 4 * (lane & 15), kq = 2 * (lane >> 4);
#pragma unroll
    for (int i = 0; i < 8; ++i) {
        const int ka = 8 * i + kq;
        f32x4 v0 = *(const f32x4*)(W + (size_t)(k0 + ka) * N + n0 + nl), v1 = *(const f32x4*)(W + (size_t)(k0 + ka + 1) * N + n0 + nl);
        if (kscale) { v0 = v0 * kscale[k0 + ka]; v1 = v1 * kscale[k0 + ka + 1]; }
#pragma unroll
        for (int j = 0; j < 4; ++j) *(LAS unsigned*)(scr + (nl + j) * 66 + ka) = pk2(v0[j], v1[j]);
    }
    asm volatile("s_waitcnt lgkmcnt(0)" ::: "memory");
    const int c = lane & 7;
#pragma unroll
    for (int j = 0; j < 8; ++j) { const int n = (lane >> 3) + 8 * j; const LAS unsigned* s = (const LAS unsigned*)(scr + n * 66 + 8 * c);
        u32x4 o; o.x = s[0]; o.y = s[1]; o.z = s[2]; o.w = s[3];
        *(u32x4*)(WT + (size_t)wt_rowmap(mode, n0 + n) * K + k0 + 8 * c) = o; }
    asm volatile("s_waitcnt lgkmcnt(0)" ::: "memory");
}
__device__ __forceinline__ void sgu_phase(LAS unsigned char* lds, const bf16_t* U, const bf16_t* VN, bf16_t* SA, const float* sgu_w, const float* sgu_b, int nchunks, int q, int G, const float* vst, const float* ln_g, const float* ln_b) {
    int tid_l = threadIdx.x; asm volatile("" : "+v"(tid_l));
    const int tid = tid_l, wave = __builtin_amdgcn_readfirstlane(tid >> 6), lane = tid & 63, l15 = lane & 15, quad = lane >> 4;
    LAS bf16_t* Wl = (LAS bf16_t*)lds;
    LAS bf16_t* Vl = (LAS bf16_t*)(lds + 128 * 136 * 2);
    const int nmt = q >> 4, nks = (q + 31) >> 5;
    int staged_g = -1;
    for (int unit = blockIdx.x; unit < nchunks * 8; unit += G) {
        const int chunk = unit >> 3, g = unit & 7, c0 = chunk * q;
        if (g != staged_g) {
            staged_g = g;
#pragma unroll
            for (int i = 0; i < 8; ++i) { const int ch = tid + 512 * i, t = ch >> 5, s4 = (ch & 31) * 4;
                const f32x4 w = *(const f32x4*)(sgu_w + ((size_t)(g * 128 + t) * 128 + s4));
                const bool tv = t < q;
                u32x2 o; o.x = pk2((tv && s4 <= t) ? w.x : 0.f, (tv && s4 + 1 <= t) ? w.y : 0.f); o.y = pk2((tv && s4 + 2 <= t) ? w.z : 0.f, (tv && s4 + 3 <= t) ? w.w : 0.f);
                *(LAS u32x2*)(Wl + t * 136 + s4) = o; }
        }
#pragma unroll
        for (int i = 0; i < 8; ++i) { const int ch = tid + 512 * i, s = ch >> 5, c8 = (ch & 31) * 8;
            u32x4 v = (u32x4){0u, 0u, 0u, 0u};
            if (s < q) v = *(const u32x4*)(VN + (size_t)(c0 + s) * 2048 + g * 256 + c8);
            if (vst && s < q) {
                const float mu = vst[2 * (c0 + s)] * (1.f / 2048.f), var = vst[2 * (c0 + s) + 1] * (1.f / 2048.f) - mu * mu, rstd = rsqrtf(var + EPSN);
                const f32x4 g0 = *(const f32x4*)(ln_g + g * 256 + c8), g1 = *(const f32x4*)(ln_g + g * 256 + c8 + 4), b0 = *(const f32x4*)(ln_b + g * 256 + c8), b1 = *(const f32x4*)(ln_b + g * 256 + c8 + 4);
                v.x = pk2((bflo(v.x) - mu) * rstd * g0[0] + b0[0], (bfhi(v.x) - mu) * rstd * g0[1] + b0[1]); v.y = pk2((bflo(v.y) - mu) * rstd * g0[2] + b0[2], (bfhi(v.y) - mu) * rstd * g0[3] + b0[3]);
                v.z = pk2((bflo(v.z) - mu) * rstd * g1[0] + b1[0], (bfhi(v.z) - mu) * rstd * g1[1] + b1[1]); v.w = pk2((bflo(v.w) - mu) * rstd * g1[2] + b1[2], (bfhi(v.w) - mu) * rstd * g1[3] + b1[3]); }
            *(LAS u32x4*)(Vl + s * 264 + c8) = v; }
        __syncthreads();
        f32x4 acc[8][2];
#pragma unroll
        for (int mt = 0; mt < 8; ++mt) { acc[mt][0] = (f32x4){0.f, 0.f, 0.f, 0.f}; acc[mt][1] = (f32x4){0.f, 0.f, 0.f, 0.f}; }
#pragma unroll
        for (int ks = 0; ks < 4; ++ks) {
            if (ks < nks) {
                bf16x8 bfr[2];
                { typedef unsigned short u16x4s __attribute__((ext_vector_type(4)));
                  u16x4s r00, r01, r10, r11;
                  const unsigned tb = (unsigned)(unsigned long)Vl + (unsigned)((32 * ks + 8 * quad + (l15 >> 2)) * 528 + (32 * wave + 4 * (lane & 3)) * 2);
                  asm volatile("ds_read_b64_tr_b16 %0, %4 offset:0\n\tds_read_b64_tr_b16 %1, %4 offset:2112\n\tds_read_b64_tr_b16 %2, %4 offset:32\n\tds_read_b64_tr_b16 %3, %4 offset:2144\n\ts_waitcnt lgkmcnt(0)"
                               : "=&v"(r00), "=&v"(r01), "=&v"(r10), "=&v"(r11) : "v"(tb) : "memory");
                  bfr[0][0] = (short)r00[0]; bfr[0][1] = (short)r00[1]; bfr[0][2] = (short)r00[2]; bfr[0][3] = (short)r00[3]; bfr[0][4] = (short)r01[0]; bfr[0][5] = (short)r01[1]; bfr[0][6] = (short)r01[2]; bfr[0][7] = (short)r01[3];
                  bfr[1][0] = (short)r10[0]; bfr[1][1] = (short)r10[1]; bfr[1][2] = (short)r10[2]; bfr[1][3] = (short)r10[3]; bfr[1][4] = (short)r11[0]; bfr[1][5] = (short)r11[1]; bfr[1][6] = (short)r11[2]; bfr[1][7] = (short)r11[3]; }
#pragma unroll
                for (int mt = 0; mt < 8; ++mt) {
                    if (mt < nmt && 16 * mt + 15 >= 32 * ks) {
                        const bf16x8 afr = *(const LAS bf16x8*)(Wl + (16 * mt + l15) * 136 + 32 * ks + 8 * quad);
                        acc[mt][0] = __builtin_amdgcn_mfma_f32_16x16x32_bf16(bfr[0], afr, acc[mt][0], 0, 0, 0);
                        acc[mt][1] = __builtin_amdgcn_mfma_f32_16x16x32_bf16(bfr[1], afr, acc[mt][1], 0, 0, 0);
                    }
                }
            }
        }
#pragma unroll
        for (int mt = 0; mt < 8; ++mt) {
            if (mt < nmt) {
                const int t = 16 * mt + l15; const size_t row = (size_t)(c0 + t); const float bias = sgu_b[g * 128 + t];
#pragma unroll
                for (int nt = 0; nt < 2; ++nt) { const int d0 = g * 256 + 32 * wave + 16 * nt + 4 * quad;
                    const u32x2 uw = *(const u32x2*)(U + row * 2048 + d0);
                    u32x2 o; o.x = pk2(bflo(uw.x) * (acc[mt][nt][0] + bias), bfhi(uw.x) * (acc[mt][nt][1] + bias)); o.y = pk2(bflo(uw.y) * (acc[mt][nt][2] + bias), bfhi(uw.y) * (acc[mt][nt][3] + bias));
                    *(u32x2*)(SA + row * 2048 + d0) = o; }
            }
        }
        __syncthreads();
    }
}

__device__ __forceinline__ void bcconv_phase(LAS unsigned char* lds, const bf16_t* XBC, bf16_t* XCBC, bf16_t* XBT, const float* hist, const float* conv_w, const float* conv_b, int nb, int L, int G) {
    int tid_l = threadIdx.x; asm volatile("" : "+v"(tid_l));
    const int tid = tid_l, wave = __builtin_amdgcn_readfirstlane(tid >> 6), lane = tid & 63;
    LAS bf16_t* T = (LAS bf16_t*)lds;
    const int nchunks = (L + 63) >> 6;
    const int qi = lane, run = wave;
    for (int unit = blockIdx.x; unit < nb * nchunks * 8; unit += G) {
        const int g = unit & 7, bc = unit >> 3, c = bc % nchunks, b = bc / nchunks;
        const int col = (qi < 32) ? 4096 + g * 128 + 4 * qi : 5120 + g * 128 + 4 * (qi - 32);
        const int ocol = (qi < 32) ? g * 128 + 4 * qi : 1024 + g * 128 + 4 * (qi - 32);
        const f32x4 cb = *(const f32x4*)(conv_b + col);
        f32x4 cw[4];
#pragma unroll
        for (int k = 0; k < 4; ++k) cw[k] = *(const f32x4*)(conv_w + k * CONVD + col);
        u32x2 raw[11];
#pragma unroll
        for (int i = 0; i < 11; ++i) { const int tl = c * 64 + 8 * run - 3 + i; u32x2 v = (u32x2){0u, 0u};
            if (tl < 0) { if (hist) { const f32x4 f = *(const f32x4*)(hist + (size_t)(b * 3 + 3 + tl) * CONVD + col); v.x = pk2(f.x, f.y); v.y = pk2(f.z, f.w); } }
            else if (tl < L) v = *(const u32x2*)(XBC + (size_t)(b * L + tl) * CONVD + col);
            raw[i] = v; }
        float sv[8][4];
#pragma unroll
        for (int i = 0; i < 8; ++i) {
            const int tl = c * 64 + 8 * run + i; const bool valid = tl < L;
            float v0 = cb.x, v1 = cb.y, v2 = cb.z, v3 = cb.w;
#pragma unroll
            for (int k = 0; k < 4; ++k) { const u32x2 rw = raw[i + k];
                v0 += bflo(rw.x) * cw[k].x; v1 += bfhi(rw.x) * cw[k].y; v2 += bflo(rw.y) * cw[k].z; v3 += bfhi(rw.y) * cw[k].w; }
            sv[i][0] = valid ? v0 * sigm(v0) : 0.f; sv[i][1] = valid ? v1 * sigm(v1) : 0.f; sv[i][2] = valid ? v2 * sigm(v2) : 0.f; sv[i][3] = valid ? v3 * sigm(v3) : 0.f;
            if (valid) { u32x2 o; o.x = pk2(sv[i][0], sv[i][1]); o.y = pk2(sv[i][2], sv[i][3]); *(u32x2*)(XCBC + (size_t)(b * L + tl) * 2048 + ocol) = o; }
        }
    }
}

__device__ __forceinline__ void ssd_phase(LAS unsigned char* lds, const bf16_t* XBC, const bf16_t* XCBC, const bf16_t* XBT, const float* DT, const bf16_t* Zs, bf16_t* Y,
                                          const float* hist, const float* h0, float* hout, const float* conv_w, const float* conv_b, const float* a_log, const float* d_skip,
                                          int nb, int L, int G) {
    int tid_l = threadIdx.x; asm volatile("" : "+v"(tid_l));
    const int tid = tid_l, wave = __builtin_amdgcn_readfirstlane(tid >> 6), lane = tid & 63, l15 = lane & 15, quad = lane >> 4;
    LAS float* xs_nat = (LAS float*)(lds);
    LAS bf16_t* xdtT = (LAS bf16_t*)(lds + 17408);
    LAS bf16_t* xtlT = (LAS bf16_t*)(lds + 26624);
    LAS bf16_t* Bnat = (LAS bf16_t*)(lds + 35840);
    LAS bf16_t* BT = (LAS bf16_t*)(lds + 53248);
    LAS bf16_t* Cnat = (LAS bf16_t*)(lds + 71680);
    LAS bf16_t* Ml = (LAS bf16_t*)(lds + 89088);
    LAS bf16_t* Hl = (LAS bf16_t*)(lds + 98304);
    LAS float* scal = (LAS float*)(lds + 115712);
    const int nchunks = (L + 63) >> 6;
    const int qi = tid & 15, rp = tid >> 4;
    const int tt = wave >> 1, wlo = wave & 1;
    int stepctr = 0;
    for (int unit0 = blockIdx.x; unit0 < nb * 64; unit0 += G) {
        int unit = unit0;
        if (G == 256) { const int x = unit0 & 255, slot = x >> 3; unit = (unit0 & ~255) + ((((x & 7) << 2) + (slot >> 3)) << 3) + (slot & 7); }
        const int b = unit >> 6, h = unit & 63, g = h >> 3;
        const float aneg = -__expf(a_log[h]), Dh = d_skip[h];
        const int col = h * 64 + 4 * qi;
        const f32x4 cb = *(const f32x4*)(conv_b + col);
        f32x4 cw[4];
#pragma unroll
        for (int k = 0; k < 4; ++k) cw[k] = *(const f32x4*)(conv_w + k * CONVD + col);
        f32x4 hacc[4];
#pragma unroll
        for (int i = 0; i < 4; ++i) {
            if (h0) hacc[i] = *(const f32x4*)(h0 + ((size_t)(b * 64 + h) * 64 + 16 * tt + l15) * 128 + 16 * (wlo * 4 + i) + 4 * quad);
            else hacc[i] = (f32x4){0.f, 0.f, 0.f, 0.f};
        }
        u32x2 raw[5]; u32x4 bq[2], cq[2]; float dtn = 0.f;
#define SSD_LOAD(cc) do { \
            _Pragma("unroll") for (int i = 0; i < 5; ++i) { const int tl = (cc) * 64 + 2 * rp - 3 + i; u32x2 v = (u32x2){0u, 0u}; \
                if (tl < 0) { if (hist) { const f32x4 f = *(const f32x4*)(hist + (size_t)(b * 3 + 3 + tl) * CONVD + col); v.x = pk2(f.x, f.y); v.y = pk2(f.z, f.w); } } \
                else if (tl < L) v = *(const u32x2*)(XBC + (size_t)(b * L + tl) * CONVD + col); \
                raw[i] = v; } \
            _Pragma("unroll") for (int j = 0; j < 2; ++j) { const int ch = tid + 512 * j, s = ch >> 4, c8 = (ch & 15) * 8, tl = (cc) * 64 + s; \
                bq[j] = (u32x4){0u, 0u, 0u, 0u}; cq[j] = (u32x4){0u, 0u, 0u, 0u}; \
                if (tl < L) { const bf16_t* src = XCBC + (size_t)(b * L + tl) * 2048 + g * 128 + c8; bq[j] = *(const u32x4*)src; cq[j] = *(const u32x4*)(src + 1024); } } \
            if (wave == 0) { const int tl = (cc) * 64 + lane; dtn = (tl < L) ? DT[(size_t)(b * L + tl) * 64 + h] : 0.f; } \
        } while (0)
        SSD_LOAD(0);
        for (int c = 0; c < nchunks; ++c) {
            LAS float* sc = scal + (stepctr & 1) * 320;
            if (wave == 0) {
                const float dtv = dtn; float cum = dtv * aneg;
#pragma unroll
                for (int o = 1; o < 64; o <<= 1) { const float v = __shfl_up(cum, o); if (lane >= o) cum += v; }
                const float cumL = __shfl(cum, 63);
                sc[lane] = dtv; sc[64 + lane] = cum; sc[128 + lane] = __expf(cum); sc[192 + lane] = dtv * __expf(cumL - cum);
                if (lane == 0) sc[256] = __expf(cumL);
            }
            u32x2 zr[2];
            { const int tl = c * 64 + 16 * tt + l15;
#pragma unroll
              for (int pi = 0; pi < 2; ++pi) zr[pi] = (tl < L) ? *(const u32x2*)(Zs + (size_t)(b * L + tl) * DSSM + h * 64 + 16 * (wlo * 2 + pi) + 4 * quad) : (u32x2){0u, 0u}; }
            __syncthreads();
            {
                float sv[2][4];
#pragma unroll
                for (int e = 0; e < 2; ++e) {
                    const bool valid = (c * 64 + 2 * rp + e) < L;
                    float v0 = cb.x, v1 = cb.y, v2 = cb.z, v3 = cb.w;
#pragma unroll
                    for (int k = 0; k < 4; ++k) { const u32x2 rw = raw[e + k];
                        v0 += bflo(rw.x) * cw[k].x; v1 += bfhi(rw.x) * cw[k].y; v2 += bflo(rw.y) * cw[k].z; v3 += bfhi(rw.y) * cw[k].w; }
                    sv[e][0] = valid ? v0 * sigm(v0) : 0.f; sv[e][1] = valid ? v1 * sigm(v1) : 0.f; sv[e][2] = valid ? v2 * sigm(v2) : 0.f; sv[e][3] = valid ? v3 * sigm(v3) : 0.f;
                }
                const int t = 2 * rp;
                *(LAS f32x4*)(xs_nat + t * 68 + 4 * qi) = (f32x4){sv[0][0], sv[0][1], sv[0][2], sv[0][3]};
                *(LAS f32x4*)(xs_nat + (t + 1) * 68 + 4 * qi) = (f32x4){sv[1][0], sv[1][1], sv[1][2], sv[1][3]};
                const float d0 = sc[t], d1 = sc[t + 1], e0 = sc[192 + t], e1 = sc[192 + t + 1];
                const int tsw = ((((t >> 3) ^ (qi & 7)) << 3) + (t & 7));
#pragma unroll
                for (int k = 0; k < 4; ++k) { *(LAS unsigned*)(xdtT + (4 * qi + k) * 72 + tsw) = pk2(sv[0][k] * d0, sv[1][k] * d1);
                    *(LAS unsigned*)(xtlT + (4 * qi + k) * 72 + tsw) = pk2(sv[0][k] * e0, sv[1][k] * e1); }
#pragma unroll
                for (int j = 0; j < 2; ++j) { const int ch = tid + 512 * j;
                    *(LAS u32x4*)(Bnat + (ch >> 4) * 136 + (ch & 15) * 8) = bq[j]; *(LAS u32x4*)(Cnat + (ch >> 4) * 136 + (ch & 15) * 8) = cq[j]; }
            }
            if (c + 1 < nchunks) SSD_LOAD(c + 1);
            __syncthreads();
            bf16x8 Cfr[4];
#pragma unroll
            for (int kn = 0; kn < 4; ++kn) Cfr[kn] = *(const LAS bf16x8*)(Cnat + (16 * tt + l15) * 136 + 32 * kn + 8 * quad);
            { const int t = 16 * tt + l15; const float ct = sc[64 + t];
#pragma unroll
              for (int si = 0; si < 2; ++si) { const int st = wlo * 2 + si;
                f32x4 acc = (f32x4){0.f, 0.f, 0.f, 0.f};
#pragma unroll
                for (int kn = 0; kn < 4; ++kn) { const bf16x8 bfr = *(const LAS bf16x8*)(Bnat + (16 * st + l15) * 136 + 32 * kn + 8 * quad);
                    acc = __builtin_amdgcn_mfma_f32_16x16x32_bf16(bfr, Cfr[kn], acc, 0, 0, 0); }
                const int s0 = 16 * st + 4 * quad; const f32x4 cs = *(const LAS f32x4*)(sc + 64 + s0);
                float m[4];
#pragma unroll
                for (int jj = 0; jj < 4; ++jj) m[jj] = (s0 + jj <= t) ? acc[jj] * __expf(ct - cs[jj]) : 0.f;
                u32x2 o; o.x = pk2(m[0], m[1]); o.y = pk2(m[2], m[3]);
                *(LAS u32x2*)(Ml + t * 72 + s0) = o; }
            }
#pragma unroll
            for (int i = 0; i < 4; ++i) { u32x2 o; o.x = pk2(hacc[i][0], hacc[i][1]); o.y = pk2(hacc[i][2], hacc[i][3]);
                *(LAS u32x2*)(Hl + (16 * tt + l15) * 136 + 16 * (wlo * 4 + i) + 4 * quad) = o; }
            __syncthreads();
            { const int t = 16 * tt + l15, tl = c * 64 + t; const float ec = sc[128 + t];
#pragma unroll
              for (int pi = 0; pi < 2; ++pi) { const int pp = wlo * 2 + pi;
                f32x4 acc = (f32x4){0.f, 0.f, 0.f, 0.f};
#pragma unroll
                for (int kn = 0; kn < 4; ++kn) { const bf16x8 hfr = *(const LAS bf16x8*)(Hl + (16 * pp + l15) * 136 + 32 * kn + 8 * quad);
                    acc = __builtin_amdgcn_mfma_f32_16x16x32_bf16(hfr, Cfr[kn], acc, 0, 0, 0); }
                acc = acc * ec;
#pragma unroll
                for (int ks = 0; ks < 2; ++ks) {
                    if (ks == 0 || tt >= 2) {
                        const bf16x8 xfr = *(const LAS bf16x8*)(xdtT + (16 * pp + l15) * 72 + (((4 * ks + quad) ^ (((16 * pp + l15) >> 2) & 7)) << 3));
                        const bf16x8 mfr = *(const LAS bf16x8*)(Ml + (16 * tt + l15) * 72 + 32 * ks + 8 * quad);
                        acc = __builtin_amdgcn_mfma_f32_16x16x32_bf16(xfr, mfr, acc, 0, 0, 0);
                    }
                }
                const int p0 = 16 * pp + 4 * quad;
                const f32x4 xs = *(const LAS f32x4*)(xs_nat + t * 68 + p0);
                const u32x2 zw = zr[pi];
                u32x2 o; o.x = pk2((acc[0] + Dh * xs[0]) * bflo(zw.x), (acc[1] + Dh * xs[1]) * bfhi(zw.x)); o.y = pk2((acc[2] + Dh * xs[2]) * bflo(zw.y), (acc[3] + Dh * xs[3]) * bfhi(zw.y));
                if (tl < L) *(u32x2*)(Y + (size_t)(b * L + tl) * DSSM + h * 64 + p0) = o; }
            }
            const float eL = sc[256];
            typedef unsigned short u16x4t __attribute__((ext_vector_type(4)));
            u16x4t tr[4][2][2];
            { const unsigned tb = (unsigned)(unsigned long)Bnat + (unsigned)((8 * quad + (l15 >> 2)) * 272 + (64 * wlo + 4 * (lane & 3)) * 2);
              asm volatile(
                "ds_read_b64_tr_b16 %0, %16 offset:0\n\t"    "ds_read_b64_tr_b16 %1, %16 offset:1088\n\t"
                "ds_read_b64_tr_b16 %2, %16 offset:8704\n\t" "ds_read_b64_tr_b16 %3, %16 offset:9792\n\t"
                "ds_read_b64_tr_b16 %4, %16 offset:32\n\t"   "ds_read_b64_tr_b16 %5, %16 offset:1120\n\t"
                "ds_read_b64_tr_b16 %6, %16 offset:8736\n\t" "ds_read_b64_tr_b16 %7, %16 offset:9824\n\t"
                "ds_read_b64_tr_b16 %8, %16 offset:64\n\t"   "ds_read_b64_tr_b16 %9, %16 offset:1152\n\t"
                "ds_read_b64_tr_b16 %10, %16 offset:8768\n\t" "ds_read_b64_tr_b16 %11, %16 offset:9856\n\t"
                "ds_read_b64_tr_b16 %12, %16 offset:96\n\t"  "ds_read_b64_tr_b16 %13, %16 offset:1184\n\t"
                "ds_read_b64_tr_b16 %14, %16 offset:8800\n\t" "ds_read_b64_tr_b16 %15, %16 offset:9888\n\t"
                "s_waitcnt lgkmcnt(0)"
                : "=&v"(tr[0][0][0]), "=&v"(tr[0][0][1]), "=&v"(tr[0][1][0]), "=&v"(tr[0][1][1]),
                  "=&v"(tr[1][0][0]), "=&v"(tr[1][0][1]), "=&v"(tr[1][1][0]), "=&v"(tr[1][1][1]),
                  "=&v"(tr[2][0][0]), "=&v"(tr[2][0][1]), "=&v"(tr[2][1][0]), "=&v"(tr[2][1][1]),
                  "=&v"(tr[3][0][0]), "=&v"(tr[3][0][1]), "=&v"(tr[3][1][0]), "=&v"(tr[3][1][1])
                : "v"(tb) : "memory"); }
#pragma unroll
            for (int i = 0; i < 4; ++i) {
                f32x4 acc = hacc[i] * eL;
#pragma unroll
                for (int ks = 0; ks < 2; ++ks) {
                    bf16x8 btf;
                    btf[0] = (short)tr[i][ks][0][0]; btf[1] = (short)tr[i][ks][0][1]; btf[2] = (short)tr[i][ks][0][2]; btf[3] = (short)tr[i][ks][0][3];
                    btf[4] = (short)tr[i][ks][1][0]; btf[5] = (short)tr[i][ks][1][1]; btf[6] = (short)tr[i][ks][1][2]; btf[7] = (short)tr[i][ks][1][3];
                    const bf16x8 xtf = *(const LAS bf16x8*)(xtlT + (16 * tt + l15) * 72 + (((4 * ks + quad) ^ (((16 * tt + l15) >> 2) & 7)) << 3));
                    acc = __builtin_amdgcn_mfma_f32_16x16x32_bf16(btf, xtf, acc, 0, 0, 0);
                }
                hacc[i] = acc; }
            ++stepctr;
        }
#undef SSD_LOAD
#pragma unroll
        for (int i = 0; i < 4; ++i) *(f32x4*)(hout + ((size_t)(b * 64 + h) * 64 + 16 * tt + l15) * 128 + 16 * (wlo * 4 + i) + 4 * quad) = hacc[i];
    }
    __syncthreads();
}

#ifndef PH_MASK
#define PH_MASK 0xFFFF
#endif
#define PH(k) if ((PH_MASK >> (k)) & 1)
#ifndef PROBE
#define PROBE 0
#endif
#define GBAR() do { gbar(barctr, bartgt, (unsigned)G); if ((PROBE >> 21) & 1) gbar(barctr, bartgt, (unsigned)G); } while (0)
#define PRB(bit) for (int prb_ = 0; prb_ < (((PROBE >> (bit)) & 1) ? 2 : 1); ++prb_)
struct Args { const float* in[24]; float* out; unsigned char* ws; };

__global__ void __launch_bounds__(512, 2) fwd_kernel(Args a) {
    extern __shared__ __attribute__((aligned(16))) unsigned char lds_raw[];
    LAS unsigned char* lds = (LAS unsigned char*)lds_raw;
    cg::grid_group grid = cg::this_grid();
    const int G = gridDim.x, tid = threadIdx.x, wave = __builtin_amdgcn_readfirstlane(tid >> 6), lane = tid & 63;
    const int gw = blockIdx.x * 8 + wave, NGW = G * 8;
    unsigned char* ws = a.ws;
    bf16_t* WIN = (bf16_t*)(ws + WS_WIN); bf16_t* WA = (bf16_t*)(ws + WS_WA); bf16_t* WB = (bf16_t*)(ws + WS_WB); bf16_t* WO = (bf16_t*)(ws + WS_WO);
    bf16_t* WUP = (bf16_t*)(ws + WS_WUP); bf16_t* WDN = (bf16_t*)(ws + WS_WDN);
    bf16_t* HB = (bf16_t*)(ws + WS_H); bf16_t* UB = (bf16_t*)(ws + WS_U); bf16_t* VB = (bf16_t*)(ws + WS_V); bf16_t* ZB = (bf16_t*)(ws + WS_Z);
    bf16_t* XB = (bf16_t*)(ws + WS_XBC); bf16_t* GB = (bf16_t*)(ws + WS_G); bf16_t* YB = (bf16_t*)(ws + WS_Y); float* DTB = (float*)(ws + WS_DT);
    float* TAILB = (float*)(ws + WS_TAIL); bf16_t* MGB = (bf16_t*)(ws + WS_MG); bf16_t* ACTB = (bf16_t*)(ws + WS_ACT);
    bf16_t* XCBC = (bf16_t*)(ws + WS_H); bf16_t* XBT = (bf16_t*)(ws + WS_XBT); float* SSQ = (float*)(ws + WS_SSQ);
    unsigned* barctr = (unsigned*)(ws + WS_BAR); unsigned bartgt = 0;
    float* VST = (float*)(ws + WS_VST);

    {
        LAS bf16_t* scr = (LAS bf16_t*)(lds + wave * 8448);
        constexpr int I_IN = 32 * 289, I_A = 32 * 32, I_B = 64 * 32, I_O = 32 * 32, I_G = 32 * 88, I_U = 32 * 88, I_D = 88 * 32;
        constexpr int NITEMS = I_IN + I_A + I_B + I_O + I_G + I_U + I_D;
        for (int it = gw; it < NITEMS; it += NGW) {
            int r = it;
            if (r < I_IN) { transpose_item(a.in[5], 2048, 18496, WIN, scr, r, lane, 1, nullptr); continue; } r -= I_IN;
            if (r < I_A) { transpose_item(a.in[10], 2048, 2048, WA, scr, r, lane, 0, nullptr); continue; } r -= I_A;
            if (r < I_B) { transpose_item(a.in[17], 4096, 2048, WB, scr, r, lane, 0, a.in[16]); continue; } r -= I_B;
            if (r < I_O) { transpose_item(a.in[18], 2048, 2048, WO, scr, r, lane, 0, nullptr); continue; } r -= I_O;
            if (r < I_G) { transpose_item(a.in[20], 2048, 5632, WUP, scr, r, lane, 2, a.in[19]); continue; } r -= I_G;
            if (r < I_U) { transpose_item(a.in[21], 2048, 5632, WUP, scr, r, lane, 3, a.in[19]); continue; } r -= I_U;
            transpose_item(a.in[22], 5632, 2048, WDN, scr, r, lane, 0, nullptr);
        }
        u32x4* zp = (u32x4*)(WIN + (size_t)18496 * 2048);
        for (int i = blockIdx.x * 512 + tid; i < 192 * 2048 / 8; i += G * 512) zp[i] = (u32x4){0u, 0u, 0u, 0u};
    }

    unsigned char* sws = ws + WS_SMP;
    for (int s = 0; s < 2; ++s) {
        const int nsub = s + 1;
#define SUB_PARAMS(j) \
        const bool smp = ((j) == 1); \
        const int R = smp ? 512 : 16384, nb = smp ? 32 : 4, L = smp ? 16 : 4096; \
        RowMap rm; rm.Ls = smp ? 4 : 12; rm.Lfull = smp ? 16 : 8192; rm.toff = smp ? 0 : s * 4096; \
        const float* xin = smp ? a.in[1] : a.in[0]; \
        float* yout = a.out + (smp ? O_YS : O_YP); \
        const float* hist = smp ? a.in[3] : (s == 1 ? TAILB : nullptr); \
        const float* h0 = smp ? a.in[2] : (s == 1 ? a.out + O_SSMP : nullptr); \
        float* hout = a.out + (smp ? O_SSMS : O_SSMP); \
        float* taildst = smp ? a.out + O_CONVS : (s == 1 ? a.out + O_CONVP : TAILB); \
        bf16_t* bH = smp ? (bf16_t*)(sws + 0 * MiB) : HB;      \
        bf16_t* bU = smp ? (bf16_t*)(sws + 2 * MiB) : UB; \
        bf16_t* bV = smp ? (bf16_t*)(sws + 4 * MiB) : VB; \
        bf16_t* bZ = smp ? (bf16_t*)(sws + 6 * MiB) : ZB; \
        bf16_t* bX = smp ? (bf16_t*)(sws + 10 * MiB) : XB;     \
        bf16_t* bG = smp ? (bf16_t*)(sws + 16 * MiB) : GB; \
        bf16_t* bY = smp ? (bf16_t*)(sws + 20 * MiB) : YB; \
        float* bDT = smp ? (float*)(sws + 24 * MiB) : DTB; \
        bf16_t* bXC = smp ? (bf16_t*)(sws + 25 * MiB) : XCBC; \
        bf16_t* bXT = smp ? (bf16_t*)(sws + 27 * MiB) : XBT; \
        bf16_t* bMG = smp ? (bf16_t*)(sws + 31 * MiB) : MGB; \
        bf16_t* bACT = smp ? (bf16_t*)(sws + 33 * MiB) : ACTB; \
        float* bSSQ = smp ? SSQ + 16384 : SSQ; \
        (void)R; (void)nb; (void)L; (void)rm; (void)xin; (void)yout; (void)hist; (void)h0; (void)hout; (void)taildst; (void)bH; (void)bU; (void)bV; (void)bZ; (void)bX; (void)bG; (void)bY; (void)bDT; (void)bXC; (void)bXT; (void)bMG; (void)bACT; (void)bSSQ;

        for (int j = 0; j < nsub; ++j) { SUB_PARAMS(j) rmsnorm_rows_bf16(xin, rm, a.in[4], bH, R, gw, NGW, lane); }
        for (int i = blockIdx.x * 512 + tid; i < 2 * 16384; i += G * 512) VST[i] = 0.f;
        if (s == 0) { if (blockIdx.x == 0 && tid == 0) __hip_atomic_store(barctr, 0u, __ATOMIC_RELAXED, __HIP_MEMORY_SCOPE_AGENT);
                      grid.sync(); } else GBAR();
        for (int j = 0; j < nsub; ++j) { SUB_PARAMS(j)
          pg8::Gemm g{bH, WIN, R, NIN_PAD, 2048}; pg8::StaticOrder S; S.init(R, NIN_PAD, G, smp ? (int)((blockIdx.x + G - 64) % G) : (int)blockIdx.x);
          EpiInProj E{bU, bV, bZ, bX, bG, bDT, a.in[13], smp ? nullptr : VST};
          pg8::gemm_phase<EpiInProj, pg8::StaticOrder>(lds, g, S, E, nullptr); }
        GBAR();
        for (int j = 0; j < nsub; ++j) { SUB_PARAMS(j)
          if (smp) ln_rows(bV, a.in[6], a.in[7], a.out + O_VS, R, gw, NGW, lane);
          for (int i = blockIdx.x * 512 + tid; i < nb * 3 * CONVD; i += G * 512) { const int bb = i / (3 * CONVD), rem = i % (3 * CONVD), rr = rem / CONVD, cc = rem % CONVD;
              taildst[i] = bf2f(bX[(size_t)(bb * L + L - 3 + rr) * CONVD + cc]); }
          for (int i = blockIdx.x * 512 + tid; i < R; i += G * 512) { bSSQ[i] = 0.f; bSSQ[32768 + i] = 0.f; }
          bcconv_phase(lds, bX, bXC, bXT, hist, a.in[11], a.in[12], nb, L, G); }
        GBAR();
        for (int j = 0; j < nsub; ++j) { SUB_PARAMS(j) sgu_phase(lds, bU, bV, bU, a.in[8], a.in[9], smp ? 32 : 128, smp ? 16 : 128, G, smp ? nullptr : VST, a.in[6], a.in[7]); }
        for (int j = 0; j < nsub; ++j) { SUB_PARAMS(j) ssd_phase(lds, bX, bXC, bXT, bDT, bZ, bY, hist, h0, hout, a.in[11], a.in[12], a.in[14], a.in[15], nb, L, G); }
        GBAR();
        for (int st = 0; st < 2; ++st) {
          const bool normNow = ((st == 0) == (((blockIdx.x >> 3) & 1) == 0));
          if (normNow) { for (int j = 0; j < nsub; ++j) { SUB_PARAMS(j) gnorm_rows(bY, R, gw, NGW, lane); } }
          else { for (int j = 0; j < nsub; ++j) { SUB_PARAMS(j)
            pg8::Gemm g{bU, WA, R, 2048, 2048}; pg8::StaticOrder S; S.init(R, 2048, G, (int)blockIdx.x);
            EpiGate<false> E{bMG, bG, 0};
            pg8::gemm_phase<EpiGate<false>, pg8::StaticOrder>(lds, g, S, E, nullptr); } }
        }
        GBAR();
        for (int j = 0; j < nsub; ++j) { SUB_PARAMS(j)
          pg8::Gemm g{bY, WB, R, 2048, 4096}; pg8::StaticOrder S; S.init(R, 2048, G, (int)blockIdx.x);
          EpiGate<true> E{bMG, bG, 2048};
          pg8::gemm_phase<EpiGate<true>, pg8::StaticOrder>(lds, g, S, E, nullptr); }
        GBAR();
        for (int j = 0; j < nsub; ++j) { SUB_PARAMS(j)
          pg8::Gemm g{bMG, WO, R, 2048, 2048}; pg8::StaticOrder S; S.init(R, 2048, G, (int)blockIdx.x);
          EpiResidNorm E{xin, rm, bH, bSSQ};
          pg8::gemm_phase<EpiResidNorm, pg8::StaticOrder>(lds, g, S, E, nullptr); }
        GBAR();
        for (int j = 0; j < nsub; ++j) { SUB_PARAMS(j)
          pg8::Gemm g{bH, WUP, R, 2 * DFF, 2048}; pg8::StaticOrder S; S.init(R, 2 * DFF, G, (int)blockIdx.x);
          EpiSwiGLU E{bACT, bSSQ};
          pg8::gemm_phase<EpiSwiGLU, pg8::StaticOrder>(lds, g, S, E, nullptr); }
        GBAR();
        for (int j = 0; j < nsub; ++j) { SUB_PARAMS(j)
          pg8::Gemm g{bACT, WDN, R, 2048, DFF}; pg8::StaticOrder S; S.init(R, 2048, G, (int)blockIdx.x);
          EpiResidBf E{bH, bU, bSSQ + 32768};
          pg8::gemm_phase<EpiResidBf, pg8::StaticOrder>(lds, g, S, E, nullptr); }
        GBAR();
        for (int j = 0; j < nsub; ++j) { SUB_PARAMS(j) final_rows(bU, bSSQ + 32768, yout, rm, a.in[23], R, gw, NGW, lane); }
#undef SUB_PARAMS
    }
}

extern "C" void kernel_launch(void* const* d_in, const int* in_sizes, int n_in, void* d_out, int out_size, void* d_ws, size_t ws_size, hipStream_t stream) {
    static int grid_blocks = 0;
    if (!grid_blocks) {
        int dev = 0, cus = 0, per_cu = 0;
        hipGetDevice(&dev);
        hipDeviceGetAttribute(&cus, hipDeviceAttributeMultiprocessorCount, dev);
        hipFuncSetAttribute((const void*)fwd_kernel, hipFuncAttributeMaxDynamicSharedMemorySize, LDS_BYTES);
        hipOccupancyMaxActiveBlocksPerMultiprocessor(&per_cu, (const void*)fwd_kernel, 512, LDS_BYTES);
        if (per_cu < 1) per_cu = 1;
        grid_blocks = cus * per_cu;
        if (ws_size < WS_END || n_in != 24) fprintf(stderr, "kernel_launch: unexpected ws_size %zu (need %zu) or n_in %d\n", ws_size, (size_t)WS_END, n_in);
    }
    Args a{};
    for (int i = 0; i < 24; ++i) a.in[i] = (const float*)d_in[i];
    a.out = (float*)d_out; a.ws = (unsigned char*)d_ws;
    void* args[] = {&a};
    hipError_t e = hipLaunchCooperativeKernel((const void*)fwd_kernel, dim3(grid_blocks), dim3(512), args, LDS_BYTES, stream);
    if (e != hipSuccess) fprintf(stderr, "cooperative launch failed: %s (grid %d)\n", hipGetErrorString(e), grid_blocks);
}
```

```cpp
#include <hip/hip_runtime.h>
#include <hip/hip_cooperative_groups.h>
#include <cstdio>
namespace cg = cooperative_groups;
namespace pg8 {
#define PG8_LAS __attribute__((address_space(3)))
typedef unsigned short bf16_t;
typedef short bf16x8 __attribute__((ext_vector_type(8)));
typedef float f32x4 __attribute__((ext_vector_type(4)));
typedef unsigned u32x4 __attribute__((ext_vector_type(4)));
constexpr int BM = 256, BK = 64, HALF = 128, HTB = HALF * BK * 2  , STAGE_BYTES = 8 * HTB, NXCD = 8, WGM = 8;

__host__ __device__ __forceinline__ int lds_byte(int r, int c) { const int st = (r >> 4) * 2 + (c >> 5), rr = r & 15, cc = c & 31, ob = rr * 64 + cc * 2; return st * 1024 + (ob ^ (((ob >> 9) & 1) << 5)); }
__host__ __device__ __forceinline__ void stage_rc(int b, int& R, int& C) { const int st = b / 1024, sb = b % 1024, swz = sb ^ (((sb >> 9) & 1) << 5); R = (st >> 1) * 16 + swz / 64; C = (st & 1) * 32 + (swz % 64) / 2; }
__host__ __device__ __forceinline__ int perm32(int rho) { const int n = rho >> 4, i = rho & 15; return 8 * (i >> 2) + 4 * n + (i & 3); }

struct Unit { int pm, pn; };
struct Gemm { const bf16_t* A; const bf16_t* Bt; int M, N, K; };

struct StaticOrder {
    int nM, nN, nwg, G, c;
    __host__ __device__ void init(int M, int N, int G_, int c_) { nM = M / BM; nN = N / BM; nwg = nM * nN; G = G_; c = c_; }
    __host__ __device__ bool next(int i, Unit& u) const {
        const long L = (long)i * G + c; if (L >= nwg) return false;
        int wgid = (int)L; { const int q = nwg / NXCD, r = nwg % NXCD, xcd = wgid % NXCD, off = wgid / NXCD; wgid = (xcd < r ? xcd * (q + 1) : r * (q + 1) + (xcd - r) * q) + off; }
        const int nig = WGM * nN, gid = wgid / nig, fm = gid * WGM, gsz = (nM - fm) < WGM ? (nM - fm) : WGM;
        u.pm = fm + ((wgid % nig) % gsz); u.pn = (wgid % nig) / gsz; return true;
    }
    __device__ __forceinline__ void a_ready(const Unit&) const {}
    __device__ __forceinline__ void done(const Unit&) const {}
};
__device__ __forceinline__ unsigned cvt_pk_bf16(float lo, float hi) { unsigned r; asm volatile("v_cvt_pk_bf16_f32 %0, %1, %2" : "=v"(r) : "v"(lo), "v"(hi)); return r; }
template <class Epi, class Sched, bool STAMP = false>
__device__ __forceinline__ void gemm_phase(PG8_LAS unsigned char* lds, const Gemm g, const Sched& S, const Epi& E, unsigned long long* stamps) {
    int tid_l = threadIdx.x; asm volatile("" : "+v"(tid_l));
    const int tid = tid_l, wid = __builtin_amdgcn_readfirstlane(tid >> 6), lane = tid & 63, wr = wid >> 2, wc = wid & 3, fr = lane & 15, fq = lane >> 4;
    const int K = g.K, nt = K / BK;
    int ts_lo = 0, ts_hi = 0, nts = 0; const unsigned long long rt_entry = STAMP ? (unsigned long long)wall_clock64() : 0ull;
#define PG8_STAMP() do { if (STAMP && wid == 0 && nts < 64) { const unsigned long long _c = (unsigned long long)clock64(); \
        ts_lo = (lane == nts) ? (int)(unsigned)_c : ts_lo; ts_hi = (lane == nts) ? (int)(unsigned)(_c >> 32) : ts_hi; ++nts; } } while (0)
    PG8_STAMP();
    unsigned voffA[2], voffB[2];
#pragma unroll
    for (int i = 0; i < 2; ++i) { int R, C; stage_rc(tid * 16 + i * 8192, R, C); const int Rb = Epi::PERM ? ((R & ~31) + perm32(R & 31)) : R;
        voffA[i] = (unsigned)(R * K + C) * 2u; voffB[i] = (unsigned)(Rb * K + C) * 2u; }
    const size_t kstep = (size_t)(BK * 2);
    const size_t hstep = (size_t)HALF * K * 2;
    const size_t tstep = 2 * hstep;
    const unsigned ldsw = (unsigned)wid * 1024u;
    const int aoff = lds_byte(wr * 64 + fr, fq * 8), boff = lds_byte(wc * 32 + fr, fq * 8);
#define PG8_SA(b, h) (((b) * 2 + (h)) * HTB)
#define PG8_SB(b, h) ((4 + (b) * 2 + (h)) * HTB)
#define PG8_STAGE(bufoff, gbase, voff) do { _Pragma("unroll") for (int _i = 0; _i < 2; ++_i) \
        __builtin_amdgcn_global_load_lds((const unsigned*)((const char*)(gbase) + (voff)[_i]), (PG8_LAS unsigned*)(lds + (bufoff) + ldsw + _i * 8192), 16, 0, 0); } while (0)
#define PG8_LDA(dst, b, h) do { _Pragma("unroll") for (int m = 0; m < 4; ++m) _Pragma("unroll") for (int k = 0; k < 2; ++k) dst[m][k] = *(const PG8_LAS bf16x8*)(lds + PG8_SA(b, h) + aoff + m * 2048 + k * 1024); } while (0)
#define PG8_LDB(dst, b, h) do { _Pragma("unroll") for (int n = 0; n < 2; ++n) _Pragma("unroll") for (int k = 0; k < 2; ++k) dst[n][k] = *(const PG8_LAS bf16x8*)(lds + PG8_SB(b, h) + boff + n * 2048 + k * 1024); } while (0)
#define PG8_MMA(ai, bj, At, Bt) do { __builtin_amdgcn_s_setprio(1); _Pragma("unroll") for (int m = 0; m < 4; ++m) _Pragma("unroll") for (int n = 0; n < 2; ++n) _Pragma("unroll") for (int k = 0; k < 2; ++k) \
        acc[ai][bj][m][n] = __builtin_amdgcn_mfma_f32_16x16x32_bf16(Bt[n][k], At[m][k], acc[ai][bj][m][n], 0, 0, 0); __builtin_amdgcn_s_setprio(0); } while (0)
#define PG8_WAIT_V(n) asm volatile("s_waitcnt vmcnt(" #n ")" ::: "memory")
#define PG8_WAIT_L(n) asm volatile("s_waitcnt lgkmcnt(" #n ")" ::: "memory")
#define PG8_BAR __builtin_amdgcn_s_barrier()
#define PG8_SCHED __builtin_amdgcn_sched_barrier(0)
    Unit cur, nxt; int ui = 0;
    if (!S.next(0, cur)) return;
    f32x4 acc[2][2][4][2];
#pragma unroll
    for (int a = 0; a < 2; ++a)
#pragma unroll
        for (int b = 0; b < 2; ++b)
#pragma unroll
            for (int m = 0; m < 4; ++m)
#pragma unroll
                for (int n = 0; n < 2; ++n) acc[a][b][m][n] = (f32x4){0.f, 0.f, 0.f, 0.f};
    bf16x8 At[4][2], B0[2][2], B1[2][2];
    const char* cA = (const char*)g.A + (size_t)cur.pm * tstep; const char* cB = (const char*)g.Bt + (size_t)cur.pn * tstep;
    S.a_ready(cur);
    PG8_STAGE(PG8_SB(0, 0), cB, voffB); PG8_STAGE(PG8_SA(0, 0), cA, voffA); PG8_STAGE(PG8_SB(0, 1), cB + hstep, voffB); PG8_STAGE(PG8_SA(0, 1), cA + hstep, voffA);
    if (wr == 1) PG8_BAR;
    PG8_WAIT_V(4); PG8_BAR;
    PG8_STAGE(PG8_SB(1, 0), cB + kstep, voffB); PG8_STAGE(PG8_SA(1, 0), cA + kstep, voffA); PG8_STAGE(PG8_SB(1, 1), cB + hstep + kstep, voffB);
    PG8_WAIT_V(6); PG8_BAR;
    PG8_STAMP();
    for (;;) {
        const bool has_next = S.next(ui + 1, nxt);
        const char* nA = has_next ? (const char*)g.A + (size_t)nxt.pm * tstep : cA; const char* nB = has_next ? (const char*)g.Bt + (size_t)nxt.pn * tstep : cB;
        for (int t = 0; t < nt; t += 2) {
            const bool last = (t == nt - 2);
            const char* a1 = cA + (size_t)(t + 1) * kstep;
            const char* a2 = last ? nA : cA + (size_t)(t + 2) * kstep; const char* b2 = last ? nB : cB + (size_t)(t + 2) * kstep;
            const char* a3 = a2 + kstep; const char* b3 = b2 + kstep;
            if (last && has_next) S.a_ready(nxt);
            PG8_LDB(B0, 0, 0); PG8_SCHED; PG8_LDA(At, 0, 0); PG8_STAGE(PG8_SA(1, 1), a1 + hstep, voffA);
            PG8_WAIT_L(8); PG8_BAR; PG8_WAIT_L(0); PG8_MMA(0, 0, At, B0); PG8_BAR; PG8_SCHED;
            PG8_LDB(B1, 0, 1); PG8_STAGE(PG8_SB(0, 0), b2, voffB);
            PG8_BAR; PG8_WAIT_L(0); PG8_MMA(0, 1, At, B1); PG8_BAR;
            PG8_LDA(At, 0, 1); PG8_STAGE(PG8_SA(0, 0), a2, voffA);
            PG8_BAR; PG8_WAIT_L(0); PG8_MMA(1, 0, At, B0); PG8_BAR; PG8_SCHED;
            PG8_STAGE(PG8_SB(0, 1), b2 + hstep, voffB);
            PG8_WAIT_V(6); PG8_BAR; PG8_MMA(1, 1, At, B1); PG8_BAR;
            PG8_LDB(B0, 1, 0); PG8_SCHED; PG8_LDA(At, 1, 0); PG8_STAGE(PG8_SA(0, 1), a2 + hstep, voffA);
            PG8_WAIT_L(8); PG8_BAR; PG8_WAIT_L(0); PG8_MMA(0, 0, At, B0); PG8_BAR; PG8_SCHED;
            PG8_LDB(B1, 1, 1); PG8_STAGE(PG8_SB(1, 0), b3, voffB);
            PG8_BAR; PG8_WAIT_L(0); PG8_MMA(0, 1, At, B1); PG8_BAR;
            PG8_LDA(At, 1, 1); PG8_STAGE(PG8_SA(1, 0), a3, voffA);
            PG8_BAR; PG8_WAIT_L(0); PG8_MMA(1, 0, At, B0); PG8_BAR; PG8_SCHED;
            PG8_STAGE(PG8_SB(1, 1), b3 + hstep, voffB);
            PG8_WAIT_V(6); PG8_BAR; PG8_MMA(1, 1, At, B1); PG8_BAR;
        }
        PG8_STAMP();
        if constexpr (!Epi::AFTER_DRAIN) { E(acc, cur, wr, wc, fr, fq); S.done(cur); }
        PG8_STAMP();
        if (!has_next) break;
#pragma unroll
        for (int a = 0; a < 2; ++a)
#pragma unroll
            for (int b = 0; b < 2; ++b)
#pragma unroll
                for (int m = 0; m < 4; ++m)
#pragma unroll
                    for (int n = 0; n < 2; ++n) acc[a][b][m][n] = (f32x4){0.f, 0.f, 0.f, 0.f};
        cur = nxt; cA = nA; cB = nB; ++ui;
    }
    PG8_WAIT_V(0);
    if (wr == 0) PG8_BAR;
    PG8_BAR;
    if constexpr (Epi::AFTER_DRAIN) { E.fused(acc, cur, wr, wc, fr, fq, lds, wid, lane); S.done(cur); }
    PG8_STAMP();
    if (STAMP && wid == 0) { stamps[lane] = lane < nts ? (((unsigned long long)(unsigned)ts_hi << 32) | (unsigned)ts_lo) : 0ull;
        if (lane == 62) stamps[62] = rt_entry; if (lane == 63) stamps[63] = (unsigned long long)wall_clock64(); }
#undef PG8_STAMP
#undef PG8_SA
#undef PG8_SB
#undef PG8_STAGE
#undef PG8_LDA
#undef PG8_LDB
#undef PG8_MMA
#undef PG8_WAIT_V
#undef PG8_WAIT_L
#undef PG8_BAR
#undef PG8_SCHED
}
}

using pg8::bf16_t; using pg8::bf16x8; using pg8::f32x4; using pg8::u32x4;
typedef unsigned u32x2 __attribute__((ext_vector_type(2)));
#define LAS __attribute__((address_space(3)))

constexpr int DM = 2048, DSSM = 4096, CONVD = 6144, NHEAD = 64, DFF = 5632, NIN_PAD = 18688;
constexpr float EPSN = 1e-6f;
constexpr size_t MiB = (size_t)1 << 20;
constexpr size_t WS_WIN = 0, WS_WA = 73 * MiB, WS_WB = 81 * MiB, WS_WO = 97 * MiB, WS_WUP = 105 * MiB, WS_WDN = 149 * MiB;
constexpr size_t WS_H = 171 * MiB, WS_U = 235 * MiB, WS_V = 299 * MiB, WS_Z = 363 * MiB, WS_XBC = 491 * MiB, WS_G = 683 * MiB, WS_Y = 811 * MiB, WS_DT = 939 * MiB, WS_TAIL = 943 * MiB, WS_SSQ = 943 * MiB + 512 * 1024, WS_BAR = 943 * MiB + 768 * 1024, WS_VST = 943 * MiB + 832 * 1024, WS_XBT = 944 * MiB, WS_SMP = 976 * MiB, WS_END = 1015 * MiB;
constexpr size_t WS_MG = WS_XBC, WS_ACT = WS_XBC;
constexpr size_t O_YP = 0, O_YS = 67108864, O_SSMP = 68157440, O_CONVP = 70254592, O_SSMS = 70328320, O_CONVS = 87105536, O_VS = 87695360;
constexpr int LDS_BYTES = 131072;

__device__ __forceinline__ float bflo(unsigned w) { return __uint_as_float(w << 16); }
__device__ __forceinline__ float bfhi(unsigned w) { return __uint_as_float(w & 0xffff0000u); }
__device__ __forceinline__ float bf2f(bf16_t b) { return __uint_as_float(((unsigned)b) << 16); }
typedef __bf16 bf16x2_t __attribute__((ext_vector_type(2)));
typedef float f32x2c __attribute__((ext_vector_type(2)));
__device__ __forceinline__ unsigned pk2(float lo, float hi) { const f32x2c v = (f32x2c){lo, hi}; const bf16x2_t b = __builtin_convertvector(v, bf16x2_t); return __builtin_bit_cast(unsigned, b); }
__device__ __forceinline__ bf16_t f2bf(float f) { return (bf16_t)(pk2(f, 0.f) & 0xffffu); }
__device__ __forceinline__ float sigm(float a) { return __builtin_amdgcn_rcpf(1.0f + __expf(-a)); }
__device__ __forceinline__ float wave_sum(float v) {
#pragma unroll
    for (int o = 1; o < 64; o <<= 1) v += __shfl_xor(v, o);
    return v;
}
struct RowMap { int Ls, Lfull, toff;
    __device__ __forceinline__ size_t operator()(int r) const { return (size_t)(r >> Ls) * Lfull + toff + (r & ((1 << Ls) - 1)); } };

typedef float f32x2 __attribute__((ext_vector_type(2)));
__device__ __forceinline__ f32x2 exp2_2(f32x2 a) { f32x2 r; r.x = __builtin_amdgcn_exp2f(a.x); r.y = __builtin_amdgcn_exp2f(a.y); return r; }
__device__ __forceinline__ f32x2 rcp_2(f32x2 a) { f32x2 r; r.x = __builtin_amdgcn_rcpf(a.x); r.y = __builtin_amdgcn_rcpf(a.y); return r; }
__device__ __forceinline__ f32x2 sigm_2(f32x2 x) { return rcp_2(exp2_2(x * -1.4426950409f) + 1.0f); }
__device__ __forceinline__ f32x2 silu_2(f32x2 x) { return x * sigm_2(x); }
__device__ __forceinline__ f32x2 gelu_2(f32x2 x) { const f32x2 t = (x * x) * -0.10294324f + -2.3022082f; return x * rcp_2(exp2_2(x * t) + 1.0f); }
template <int KIND> __device__ __forceinline__ unsigned act_pk(float a, float b) {
    f32x2 v = (f32x2){a, b};
    if (KIND == 0) v = gelu_2(v); else if (KIND == 1) v = silu_2(v); else if (KIND == 3) v = sigm_2(v);
    return pk2(v.x, v.y);
}
template <int KIND> __device__ __forceinline__ void inproj_tile(const f32x4 (&acc)[2][2][4][2], bf16_t* base, int ldc, int row0, int col0) {
#pragma unroll
    for (int ai = 0; ai < 2; ++ai)
#pragma unroll
        for (int m = 0; m < 4; ++m) {
            bf16_t* rowp = base + (size_t)(row0 + ai * 128 + m * 16) * ldc + col0;
#pragma unroll
            for (int bj = 0; bj < 2; ++bj) {
                const f32x4 v0 = acc[ai][bj][m][0], v1 = acc[ai][bj][m][1];
                u32x4 w; w.x = act_pk<KIND>(v0[0], v0[1]); w.y = act_pk<KIND>(v0[2], v0[3]); w.z = act_pk<KIND>(v1[0], v1[1]); w.w = act_pk<KIND>(v1[2], v1[3]);
                *(u32x4*)(rowp + bj * 128) = w;
            }
        }
}
__device__ __forceinline__ void inproj_tile_vstats(const f32x4 (&acc)[2][2][4][2], bf16_t* base, int row0, int col0, float* vst, int fq) {
#pragma unroll
    for (int ai = 0; ai < 2; ++ai)
#pragma unroll
        for (int m = 0; m < 4; ++m) {
            const int r = row0 + ai * 128 + m * 16;
            bf16_t* rowp = base + (size_t)r * 2048 + col0;
            f32x2 s1 = (f32x2){0.f, 0.f}, s2 = (f32x2){0.f, 0.f};
#pragma unroll
            for (int bj = 0; bj < 2; ++bj) {
                const f32x4 v0 = acc[ai][bj][m][0], v1 = acc[ai][bj][m][1];
                const f32x2 a = gelu_2((f32x2){v0[0], v0[1]}), b = gelu_2((f32x2){v0[2], v0[3]}), c = gelu_2((f32x2){v1[0], v1[1]}), d = gelu_2((f32x2){v1[2], v1[3]});
                s1 += (a + b) + (c + d); s2 += (a * a + b * b) + (c * c + d * d);
                u32x4 w; w.x = pk2(a.x, a.y); w.y = pk2(b.x, b.y); w.z = pk2(c.x, c.y); w.w = pk2(d.x, d.y);
                *(u32x4*)(rowp + bj * 128) = w;
            }
            float t1 = s1.x + s1.y, t2 = s2.x + s2.y;
            t1 += __shfl_xor(t1, 16); t1 += __shfl_xor(t1, 32); t2 += __shfl_xor(t2, 16); t2 += __shfl_xor(t2, 32);
            if (fq == 0) { atomicAdd(vst + 2 * r, t1); atomicAdd(vst + 2 * r + 1, t2); }
        }
}
__device__ __forceinline__ float act_k(float x, int kind) {
    const float a = (kind == 0) ? 1.5957691216f * (x + 0.044715f * x * x * x) : x;
    const float s = sigm(a);
    return kind == 3 ? s : (kind == 2 ? x : x * s);
}
struct EpiInProj {
    static constexpr bool PERM = true, AFTER_DRAIN = false;
    bf16_t *U, *V, *Z, *XBC, *G; float* DT; const float* dt_bias; float* vst;
    __device__ __forceinline__ void operator()(const f32x4 (&acc)[2][2][4][2], const pg8::Unit& u, int wr, int wc, int fr, int fq) const {
        const int pn = u.pn; const int row0 = u.pm * 256 + wr * 64 + fr;
        if (pn == 72) {
            if (wc < 2) {
                const int cl = wc * 32 + 8 * fq;
                const f32x4 b0 = *(const f32x4*)(dt_bias + cl), b1 = *(const f32x4*)(dt_bias + cl + 4);
#pragma unroll
                for (int ai = 0; ai < 2; ++ai)
#pragma unroll
                    for (int m = 0; m < 4; ++m) {
                        float* rp = DT + (size_t)(row0 + ai * 128 + m * 16) * 64 + cl;
                        f32x4 v0 = acc[ai][0][m][0] + b0, v1 = acc[ai][0][m][1] + b1;
#pragma unroll
                        for (int j = 0; j < 4; ++j) { v0[j] = fmaxf(v0[j], 0.f) + log1pf(__expf(-fabsf(v0[j]))); v1[j] = fmaxf(v1[j], 0.f) + log1pf(__expf(-fabsf(v1[j]))); }
                        *(f32x4*)rp = v0; *(f32x4*)(rp + 4) = v1;
                    }
            }
            return;
        }
        int kind, ldc, colt; bf16_t* base;
        if (pn < 8) { kind = 0; base = U; ldc = 2048; colt = pn * 256; }
        else if (pn < 16) { kind = 0; base = V; ldc = 2048; colt = (pn - 8) * 256; }
        else if (pn < 32) { kind = 1; base = Z; ldc = 4096; colt = (pn - 16) * 256; }
        else if (pn < 56) { kind = 2; base = XBC; ldc = 6144; colt = (pn - 32) * 256; }
        else { kind = 3; base = G; ldc = 4096; colt = (pn - 56) * 256; }
        const int col0 = colt + wc * 32 + 8 * fq;
        if (pn >= 8 && pn < 16 && vst) inproj_tile_vstats(acc, base, row0, col0, vst, fq);
        else if (kind == 0) inproj_tile<0>(acc, base, ldc, row0, col0);
        else if (kind == 1) inproj_tile<1>(acc, base, ldc, row0, col0);
        else if (kind == 2) inproj_tile<2>(acc, base, ldc, row0, col0);
        else inproj_tile<3>(acc, base, ldc, row0, col0);
    }
};
struct EpiNull {
    static constexpr bool PERM = true, AFTER_DRAIN = false;
    float* sink;
    __device__ __forceinline__ void operator()(const f32x4 (&acc)[2][2][4][2], const pg8::Unit& u, int wr, int wc, int fr, int fq) const {
        float s = 0.f;
#pragma unroll
        for (int ai = 0; ai < 2; ++ai)
#pragma unroll
            for (int bj = 0; bj < 2; ++bj)
#pragma unroll
                for (int m = 0; m < 4; ++m)
#pragma unroll
                    for (int n = 0; n < 2; ++n) s += (acc[ai][bj][m][n][0] + acc[ai][bj][m][n][1]) + (acc[ai][bj][m][n][2] + acc[ai][bj][m][n][3]);
        sink[(size_t)(u.pm * 73 + u.pn) * 512 + threadIdx.x] = s;
    }
};
template <bool ACCUM> struct EpiGate {
    static constexpr bool PERM = true, AFTER_DRAIN = false;
    bf16_t* MG; const bf16_t* Gt; int goff;
    __device__ __forceinline__ void operator()(const f32x4 (&acc)[2][2][4][2], const pg8::Unit& u, int wr, int wc, int fr, int fq) const {
        const int row0 = u.pm * 256 + wr * 64 + fr, col0 = u.pn * 256 + wc * 32 + 8 * fq;
#pragma unroll
        for (int ai = 0; ai < 2; ++ai)
#pragma unroll
            for (int m = 0; m < 4; ++m) {
                const size_t r = (size_t)(row0 + ai * 128 + m * 16);
#pragma unroll
                for (int bj = 0; bj < 2; ++bj) {
                    const int c = col0 + bj * 128;
                    const u32x4 gw = *(const u32x4*)(Gt + r * 4096 + goff + c);
                    const f32x4 v0 = acc[ai][bj][m][0], v1 = acc[ai][bj][m][1];
                    float o0 = bflo(gw.x) * v0[0], o1 = bfhi(gw.x) * v0[1], o2 = bflo(gw.y) * v0[2], o3 = bfhi(gw.y) * v0[3];
                    float o4 = bflo(gw.z) * v1[0], o5 = bfhi(gw.z) * v1[1], o6 = bflo(gw.w) * v1[2], o7 = bfhi(gw.w) * v1[3];
                    bf16_t* dst = MG + r * 2048 + c;
                    if (ACCUM) { const u32x4 pw = *(const u32x4*)dst;
                        o0 += bflo(pw.x); o1 += bfhi(pw.x); o2 += bflo(pw.y); o3 += bfhi(pw.y); o4 += bflo(pw.z); o5 += bfhi(pw.z); o6 += bflo(pw.w); o7 += bfhi(pw.w); }
                    u32x4 w; w.x = pk2(o0, o1); w.y = pk2(o2, o3); w.z = pk2(o4, o5); w.w = pk2(o6, o7);
                    *(u32x4*)dst = w;
                }
            }
    }
};
struct EpiSwiGLU {
    static constexpr bool PERM = true, AFTER_DRAIN = false;
    bf16_t* ACT; const float* SSQ;
    __device__ __forceinline__ void operator()(const f32x4 (&acc)[2][2][4][2], const pg8::Unit& u, int wr, int wc, int fr, int fq) const {
        const int row0 = u.pm * 256 + wr * 64 + fr, j0 = u.pn * 128 + wc * 16 + 4 * fq;
#pragma unroll
        for (int ai = 0; ai < 2; ++ai)
#pragma unroll
            for (int m = 0; m < 4; ++m) {
                bf16_t* rowp = ACT + (size_t)(row0 + ai * 128 + m * 16) * DFF + j0;
                const float rs = rsqrtf(SSQ[row0 + ai * 128 + m * 16] * (1.f / 2048.f) + EPSN);
#pragma unroll
                for (int bj = 0; bj < 2; ++bj) {
                    const f32x4 g = acc[ai][bj][m][0] * rs, up = acc[ai][bj][m][1] * rs;
                    const f32x2 o0 = silu_2((f32x2){g[0], g[1]}) * (f32x2){up[0], up[1]}, o1 = silu_2((f32x2){g[2], g[3]}) * (f32x2){up[2], up[3]};
                    u32x2 w; w.x = pk2(o0.x, o0.y); w.y = pk2(o1.x, o1.y);
                    *(u32x2*)(rowp + bj * 64) = w;
                }
            }
    }
};
struct EpiResid {
    static constexpr bool PERM = false, AFTER_DRAIN = false;
    const float* base; float* out; RowMap rm;
    __device__ __forceinline__ void operator()(const f32x4 (&acc)[2][2][4][2], const pg8::Unit& u, int wr, int wc, int fr, int fq) const {
        const int row0 = u.pm * 256 + wr * 64 + fr, col0 = u.pn * 256 + wc * 32 + 4 * fq;
#pragma unroll
        for (int ai = 0; ai < 2; ++ai)
#pragma unroll
            for (int m = 0; m < 4; ++m) {
                const size_t off = rm(row0 + ai * 128 + m * 16) * 2048 + col0;
#pragma unroll
                for (int bj = 0; bj < 2; ++bj)
#pragma unroll
                    for (int n = 0; n < 2; ++n) {
                        const f32x4 b = *(const f32x4*)(base + off + bj * 128 + n * 16);
                        *(f32x4*)(out + off + bj * 128 + n * 16) = b + acc[ai][bj][m][n];
                    }
            }
    }
};

struct EpiResidNorm {
    static constexpr bool PERM = true, AFTER_DRAIN = false;
    const float* base; RowMap rm; bf16_t* X1; float* SSQ;
    __device__ __forceinline__ void operator()(const f32x4 (&acc)[2][2][4][2], const pg8::Unit& u, int wr, int wc, int fr, int fq) const {
        const int row0 = u.pm * 256 + wr * 64 + fr, col0 = u.pn * 256 + wc * 32 + 8 * fq;
#pragma unroll
        for (int ai = 0; ai < 2; ++ai)
#pragma unroll
            for (int m = 0; m < 4; ++m) {
                const int r = row0 + ai * 128 + m * 16;
                const size_t off = rm(r) * 2048 + col0;
                float ss = 0.f;
#pragma unroll
                for (int bj = 0; bj < 2; ++bj) {
                    const f32x4 b0 = *(const f32x4*)(base + off + bj * 128), b1 = *(const f32x4*)(base + off + bj * 128 + 4);
                    const f32x4 x0 = b0 + acc[ai][bj][m][0], x1 = b1 + acc[ai][bj][m][1];
                    ss += ((x0[0] * x0[0] + x0[1] * x0[1]) + (x0[2] * x0[2] + x0[3] * x0[3])) + ((x1[0] * x1[0] + x1[1] * x1[1]) + (x1[2] * x1[2] + x1[3] * x1[3]));
                    u32x4 w; w.x = pk2(x0[0], x0[1]); w.y = pk2(x0[2], x0[3]); w.z = pk2(x1[0], x1[1]); w.w = pk2(x1[2], x1[3]);
                    *(u32x4*)(X1 + (size_t)r * 2048 + col0 + bj * 128) = w;
                }
                ss += __shfl_xor(ss, 16); ss += __shfl_xor(ss, 32);
                if (fq == 0) atomicAdd(SSQ + r, ss);
            }
    }
};
struct EpiResidBf {
    static constexpr bool PERM = true, AFTER_DRAIN = false;
    const bf16_t* X1; bf16_t* X2; float* SSQ2;
    __device__ __forceinline__ void operator()(const f32x4 (&acc)[2][2][4][2], const pg8::Unit& u, int wr, int wc, int fr, int fq) const {
        const int row0 = u.pm * 256 + wr * 64 + fr, col0 = u.pn * 256 + wc * 32 + 8 * fq;
#pragma unroll
        for (int ai = 0; ai < 2; ++ai)
#pragma unroll
            for (int m = 0; m < 4; ++m) {
                const int r = row0 + ai * 128 + m * 16;
                float ss = 0.f;
#pragma unroll
                for (int bj = 0; bj < 2; ++bj) {
                    const size_t eo = (size_t)r * 2048 + col0 + bj * 128;
                    const u32x4 xw = *(const u32x4*)(X1 + eo);
                    const f32x4 a0 = acc[ai][bj][m][0], a1 = acc[ai][bj][m][1];
                    const float y0 = bflo(xw.x) + a0[0], y1 = bfhi(xw.x) + a0[1], y2 = bflo(xw.y) + a0[2], y3 = bfhi(xw.y) + a0[3];
                    const float y4 = bflo(xw.z) + a1[0], y5 = bfhi(xw.z) + a1[1], y6 = bflo(xw.w) + a1[2], y7 = bfhi(xw.w) + a1[3];
                    ss += ((y0 * y0 + y1 * y1) + (y2 * y2 + y3 * y3)) + ((y4 * y4 + y5 * y5) + (y6 * y6 + y7 * y7));
                    u32x4 w; w.x = pk2(y0, y1); w.y = pk2(y2, y3); w.z = pk2(y4, y5); w.w = pk2(y6, y7);
                    *(u32x4*)(X2 + eo) = w;
                }
                ss += __shfl_xor(ss, 16); ss += __shfl_xor(ss, 32);
                if (fq == 0) atomicAdd(SSQ2 + r, ss);
            }
    }
};
__device__ __forceinline__ void final_rows(const bf16_t* X2, const float* SSQ2, float* out, RowMap rm, const float* g, int R, int gw, int NGW, int lane) {
    asm volatile("" : "+v"(lane)); asm volatile("" : "+s"(gw));
    for (int r = gw; r < R; r += NGW) {
        const float rstd = rsqrtf(SSQ2[r] * (1.f / 2048.f) + EPSN);
        const u32x4* xr = (const u32x4*)(X2 + (size_t)r * 2048) + lane;
        float* o = out + rm(r) * 2048;
#pragma unroll
        for (int j = 0; j < 4; ++j) { const u32x4 w = xr[64 * j]; const int c = (lane + 64 * j) * 8;
            const f32x4 g0 = *(const f32x4*)(g + c), g1 = *(const f32x4*)(g + c + 4);
            *(f32x4*)(o + c) = (f32x4){bflo(w.x) * rstd * g0[0], bfhi(w.x) * rstd * g0[1], bflo(w.y) * rstd * g0[2], bfhi(w.y) * rstd * g0[3]};
            *(f32x4*)(o + c + 4) = (f32x4){bflo(w.z) * rstd * g1[0], bfhi(w.z) * rstd * g1[1], bflo(w.w) * rstd * g1[2], bfhi(w.w) * rstd * g1[3]}; }
    }
}

__device__ __forceinline__ void gbar(unsigned* ctr, unsigned& target, unsigned G) {
    asm volatile("s_waitcnt vmcnt(0)" ::: "memory");
    __syncthreads();
    if (threadIdx.x == 0) {
        target += G;
        __builtin_amdgcn_fence(__ATOMIC_RELEASE, "agent");
        asm volatile("s_waitcnt vmcnt(0)" ::: "memory");
        __hip_atomic_fetch_add(ctr, 1u, __ATOMIC_RELAXED, __HIP_MEMORY_SCOPE_AGENT);
        while (__hip_atomic_load(ctr, __ATOMIC_RELAXED, __HIP_MEMORY_SCOPE_AGENT) < target) { }
        __builtin_amdgcn_fence(__ATOMIC_ACQUIRE, "agent");
        asm volatile("s_waitcnt vmcnt(0)" ::: "memory");
    }
    __syncthreads();
}

__device__ __forceinline__ void rmsnorm_rows_bf16(const float* src, RowMap rm, const float* g, bf16_t* dst, int R, int gw, int NGW, int lane) {
    asm volatile("" : "+v"(lane)); asm volatile("" : "+s"(gw));
    for (int r = gw; r < R; r += NGW) {
        const f32x4* xr = (const f32x4*)(src + rm(r) * 2048) + lane;
        f32x4 v[8]; float ss = 0.f;
#pragma unroll
        for (int j = 0; j < 8; ++j) { v[j] = xr[64 * j]; ss += (v[j].x * v[j].x + v[j].y * v[j].y) + (v[j].z * v[j].z + v[j].w * v[j].w); }
        const float rstd = rsqrtf(wave_sum(ss) * (1.f / 2048.f) + EPSN);
        u32x2* o = (u32x2*)(dst + (size_t)r * 2048) + lane;
#pragma unroll
        for (int j = 0; j < 8; ++j) { const f32x4 gg = ((const f32x4*)g)[lane + 64 * j];
            u32x2 w; w.x = pk2(v[j].x * rstd * gg.x, v[j].y * rstd * gg.y); w.y = pk2(v[j].z * rstd * gg.z, v[j].w * rstd * gg.w); o[64 * j] = w; }
    }
}
__device__ __forceinline__ void rmsnorm_rows_inplace(float* buf, RowMap rm, const float* g, int R, int gw, int NGW, int lane) {
    asm volatile("" : "+v"(lane)); asm volatile("" : "+s"(gw));
    for (int r = gw; r < R; r += NGW) {
        f32x4* xr = (f32x4*)(buf + rm(r) * 2048) + lane;
        f32x4 v[8]; float ss = 0.f;
#pragma unroll
        for (int j = 0; j < 8; ++j) { v[j] = xr[64 * j]; ss += (v[j].x * v[j].x + v[j].y * v[j].y) + (v[j].z * v[j].z + v[j].w * v[j].w); }
        const float rstd = rsqrtf(wave_sum(ss) * (1.f / 2048.f) + EPSN);
#pragma unroll
        for (int j = 0; j < 8; ++j) { const f32x4 gg = ((const f32x4*)g)[lane + 64 * j]; xr[64 * j] = v[j] * rstd * gg; }
    }
}
__device__ __forceinline__ void ln_rows(bf16_t* V, const float* lg, const float* lb, float* vout, int R, int gw, int NGW, int lane) {
    asm volatile("" : "+v"(lane)); asm volatile("" : "+s"(gw));
    for (int r = gw; r < R; r += NGW) {
        u32x4* vr = (u32x4*)(V + (size_t)r * 2048) + lane;
        float x[4][8]; float s = 0.f;
#pragma unroll
        for (int j = 0; j < 4; ++j) { const u32x4 w = vr[64 * j];
            x[j][0] = bflo(w.x); x[j][1] = bfhi(w.x); x[j][2] = bflo(w.y); x[j][3] = bfhi(w.y); x[j][4] = bflo(w.z); x[j][5] = bfhi(w.z); x[j][6] = bflo(w.w); x[j][7] = bfhi(w.w);
#pragma unroll
            for (int k = 0; k < 8; ++k) s += x[j][k]; }
        const float mu = wave_sum(s) * (1.f / 2048.f); float q = 0.f;
#pragma unroll
        for (int j = 0; j < 4; ++j)
#pragma unroll
            for (int k = 0; k < 8; ++k) { x[j][k] -= mu; q += x[j][k] * x[j][k]; }
        const float rstd = rsqrtf(wave_sum(q) * (1.f / 2048.f) + EPSN);
#pragma unroll
        for (int j = 0; j < 4; ++j) { const int c = (lane + 64 * j) * 8;
            const f32x4 g0 = *(const f32x4*)(lg + c), g1 = *(const f32x4*)(lg + c + 4), b0 = *(const f32x4*)(lb + c), b1 = *(const f32x4*)(lb + c + 4);
            f32x4 y0, y1;
            y0.x = x[j][0] * rstd * g0.x + b0.x; y0.y = x[j][1] * rstd * g0.y + b0.y; y0.z = x[j][2] * rstd * g0.z + b0.z; y0.w = x[j][3] * rstd * g0.w + b0.w;
            y1.x = x[j][4] * rstd * g1.x + b1.x; y1.y = x[j][5] * rstd * g1.y + b1.y; y1.z = x[j][6] * rstd * g1.z + b1.z; y1.w = x[j][7] * rstd * g1.w + b1.w;
            u32x4 w; w.x = pk2(y0.x, y0.y); w.y = pk2(y0.z, y0.w); w.z = pk2(y1.x, y1.y); w.w = pk2(y1.z, y1.w); vr[64 * j] = w;
            if (vout) { float* o = vout + (size_t)r * 2048 + c; *(f32x4*)o = y0; *(f32x4*)(o + 4) = y1; } }
    }
}
__device__ __forceinline__ void gnorm_rows(bf16_t* Y, int R, int gw, int NGW, int lane) {
    asm volatile("" : "+v"(lane)); asm volatile("" : "+s"(gw));
    for (int r = gw; r < R; r += NGW) {
        u32x4* yr = (u32x4*)(Y + (size_t)r * 4096) + lane;
#pragma unroll
        for (int j = 0; j < 8; ++j) { const u32x4 w = yr[64 * j];
            float x0 = bflo(w.x), x1 = bfhi(w.x), x2 = bflo(w.y), x3 = bfhi(w.y), x4 = bflo(w.z), x5 = bfhi(w.z), x6 = bflo(w.w), x7 = bfhi(w.w);
            const float ss = (x0 * x0 + x1 * x1) + (x2 * x2 + x3 * x3) + (x4 * x4 + x5 * x5) + (x6 * x6 + x7 * x7);
            const float rstd = rsqrtf(wave_sum(ss) * (1.f / 512.f) + EPSN);
            u32x4 o; o.x = pk2(x0 * rstd, x1 * rstd); o.y = pk2(x2 * rstd, x3 * rstd); o.z = pk2(x4 * rstd, x5 * rstd); o.w = pk2(x6 * rstd, x7 * rstd); yr[64 * j] = o; }
    }
}

__device__ __forceinline__ int wt_rowmap(int mode, int n) {
    if (mode == 1) return n < 14336 ? n : (n < 14400 ? 18432 + (n - 14336) : n - 64);
    if (mode == 2) return 8 * (n >> 2) + (n & 3);
    if (mode == 3) return 8 * (n >> 2) + 4 + (n & 3);
    return n;
}
__device__ __forceinline__ void transpose_item(const float* W, int K, int N, bf16_t* WT, LAS bf16_t* scr, int item, int lane, int mode, const float* kscale) {
    const int nblk = N / 64, kb = item / nblk, nb = item % nblk, k0 = 64 * kb, n0 = 64 * nb;
    const int nl = 4 * (lane & 15), kq = 2 * (lane >> 4);
#pragma unroll
    for (int i = 0; i < 8; ++i) {
        const int ka = 8 * i + kq;
        f32x4 v0 = *(const f32x4*)(W + (size_t)(k0 + ka) * N + n0 + nl), v1 = *(const f32x4*)(W + (size_t)(k0 + ka + 1) * N + n0 + nl);
        if (kscale) { v0 = v0 * kscale[k0 + ka]; v1 = v1 * kscale[k0 + ka + 1]; }
#pragma unroll
        for (int j = 0; j < 4; ++j) *(LAS unsigned*)(scr + (nl + j) * 66 + ka) = pk2(v0[j], v1[j]);
    }
    asm volatile("s_waitcnt lgkmcnt(0)" ::: "memory");
    const int c = lane & 7;
#pragma unroll
    for (int j = 0; j < 8; ++j) { const int n = (lane >> 3) + 8 * j; const LAS unsigned* s = (const LAS unsigned*)(scr + n * 66 + 8 * c);
        u32x4 o; o.x = s[0]; o.y = s[1]; o.z = s[2]; o.w = s[3];
        *(u32x4*)(WT + (size_t)wt_rowmap(mode, n0 + n) * K + k0 + 8 * c) = o; }
    asm volatile("s_waitcnt lgkmcnt(0)" ::: "memory");
}
__device__ __forceinline__ void sgu_phase(LAS unsigned char* lds, const bf16_t* U, const bf16_t* VN, bf16_t* SA, const float* sgu_w, const float* sgu_b, int nchunks, int q, int G, const float* vst, const float* ln_g, const float* ln_b) {
    int tid_l = threadIdx.x; asm volatile("" : "+v"(tid_l));
    const int tid = tid_l, wave = __builtin_amdgcn_readfirstlane(tid >> 6), lane = tid & 63, l15 = lane & 15, quad = lane >> 4;
    LAS bf16_t* Wl = (LAS bf16_t*)lds;
    LAS bf16_t* Vl = (LAS bf16_t*)(lds + 128 * 136 * 2);
    const int nmt = q >> 4, nks = (q + 31) >> 5;
    int staged_g = -1;
    for (int unit = blockIdx.x; unit < nchunks * 8; unit += G) {
        const int chunk = unit >> 3, g = unit & 7, c0 = chunk * q;
        if (g != staged_g) {
            staged_g = g;
#pragma unroll
            for (int i = 0; i < 8; ++i) { const int ch = tid + 512 * i, t = ch >> 5, s4 = (ch & 31) * 4;
                const f32x4 w = *(const f32x4*)(sgu_w + ((size_t)(g * 128 + t) * 128 + s4));
                const bool tv = t < q;
                u32x2 o; o.x = pk2((tv && s4 <= t) ? w.x : 0.f, (tv && s4 + 1 <= t) ? w.y : 0.f); o.y = pk2((tv && s4 + 2 <= t) ? w.z : 0.f, (tv && s4 + 3 <= t) ? w.w : 0.f);
                *(LAS u32x2*)(Wl + t * 136 + s4) = o; }
        }
#pragma unroll
        for (int i = 0; i < 8; ++i) { const int ch = tid + 512 * i, s = ch >> 5, c8 = (ch & 31) * 8;
            u32x4 v = (u32x4){0u, 0u, 0u, 0u};
            if (s < q) v = *(const u32x4*)(VN + (size_t)(c0 + s) * 2048 + g * 256 + c8);
            if (vst && s < q) {
                const float mu = vst[2 * (c0 + s)] * (1.f / 2048.f), var = vst[2 * (c0 + s) + 1] * (1.f / 2048.f) - mu * mu, rstd = rsqrtf(var + EPSN);
                const f32x4 g0 = *(const f32x4*)(ln_g + g * 256 + c8), g1 = *(const f32x4*)(ln_g + g * 256 + c8 + 4), b0 = *(const f32x4*)(ln_b + g * 256 + c8), b1 = *(const f32x4*)(ln_b + g * 256 + c8 + 4);
                v.x = pk2((bflo(v.x) - mu) * rstd * g0[0] + b0[0], (bfhi(v.x) - mu) * rstd * g0[1] + b0[1]); v.y = pk2((bflo(v.y) - mu) * rstd * g0[2] + b0[2], (bfhi(v.y) - mu) * rstd * g0[3] + b0[3]);
                v.z = pk2((bflo(v.z) - mu) * rstd * g1[0] + b1[0], (bfhi(v.z) - mu) * rstd * g1[1] + b1[1]); v.w = pk2((bflo(v.w) - mu) * rstd * g1[2] + b1[2], (bfhi(v.w) - mu) * rstd * g1[3] + b1[3]); }
            *(LAS u32x4*)(Vl + s * 264 + c8) = v; }
        __syncthreads();
        f32x4 acc[8][2];
#pragma unroll
        for (int mt = 0; mt < 8; ++mt) { acc[mt][0] = (f32x4){0.f, 0.f, 0.f, 0.f}; acc[mt][1] = (f32x4){0.f, 0.f, 0.f, 0.f}; }
#pragma unroll
        for (int ks = 0; ks < 4; ++ks) {
            if (ks < nks) {
                bf16x8 bfr[2];
                { typedef unsigned short u16x4s __attribute__((ext_vector_type(4)));
                  u16x4s r00, r01, r10, r11;
                  const unsigned tb = (unsigned)(unsigned long)Vl + (unsigned)((32 * ks + 8 * quad + (l15 >> 2)) * 528 + (32 * wave + 4 * (lane & 3)) * 2);
                  asm volatile("ds_read_b64_tr_b16 %0, %4 offset:0\n\tds_read_b64_tr_b16 %1, %4 offset:2112\n\tds_read_b64_tr_b16 %2, %4 offset:32\n\tds_read_b64_tr_b16 %3, %4 offset:2144\n\ts_waitcnt lgkmcnt(0)"
                               : "=&v"(r00), "=&v"(r01), "=&v"(r10), "=&v"(r11) : "v"(tb) : "memory");
                  bfr[0][0] = (short)r00[0]; bfr[0][1] = (short)r00[1]; bfr[0][2] = (short)r00[2]; bfr[0][3] = (short)r00[3]; bfr[0][4] = (short)r01[0]; bfr[0][5] = (short)r01[1]; bfr[0][6] = (short)r01[2]; bfr[0][7] = (short)r01[3];
                  bfr[1][0] = (short)r10[0]; bfr[1][1] = (short)r10[1]; bfr[1][2] = (short)r10[2]; bfr[1][3] = (short)r10[3]; bfr[1][4] = (short)r11[0]; bfr[1][5] = (short)r11[1]; bfr[1][6] = (short)r11[2]; bfr[1][7] = (short)r11[3]; }
#pragma unroll
                for (int mt = 0; mt < 8; ++mt) {
                    if (mt < nmt && 16 * mt + 15 >= 32 * ks) {
                        const bf16x8 afr = *(const LAS bf16x8*)(Wl + (16 * mt + l15) * 136 + 32 * ks + 8 * quad);
                        acc[mt][0] = __builtin_amdgcn_mfma_f32_16x16x32_bf16(bfr[0], afr, acc[mt][0], 0, 0, 0);
                        acc[mt][1] = __builtin_amdgcn_mfma_f32_16x16x32_bf16(bfr[1], afr, acc[mt][1], 0, 0, 0);
                    }
                }
            }
        }
#pragma unroll
        for (int mt = 0; mt < 8; ++mt) {
            if (mt < nmt) {
                const int t = 16 * mt + l15; const size_t row = (size_t)(c0 + t); const float bias = sgu_b[g * 128 + t];
#pragma unroll
                for (int nt = 0; nt < 2; ++nt) { const int d0 = g * 256 + 32 * wave + 16 * nt + 4 * quad;
                    const u32x2 uw = *(const u32x2*)(U + row * 2048 + d0);
                    u32x2 o; o.x = pk2(bflo(uw.x) * (acc[mt][nt][0] + bias), bfhi(uw.x) * (acc[mt][nt][1] + bias)); o.y = pk2(bflo(uw.y) * (acc[mt][nt][2] + bias), bfhi(uw.y) * (acc[mt][nt][3] + bias));
                    *(u32x2*)(SA + row * 2048 + d0) = o; }
            }
        }
        __syncthreads();
    }
}

__device__ __forceinline__ void bcconv_phase(LAS unsigned char* lds, const bf16_t* XBC, bf16_t* XCBC, bf16_t* XBT, const float* hist, const float* conv_w, const float* conv_b, int nb, int L, int G) {
    int tid_l = threadIdx.x; asm volatile("" : "+v"(tid_l));
    const int tid = tid_l, wave = __builtin_amdgcn_readfirstlane(tid >> 6), lane = tid & 63;
    LAS bf16_t* T = (LAS bf16_t*)lds;
    const int nchunks = (L + 63) >> 6;
    const int qi = lane, run = wave;
    int cached_g = -1; f32x4 cb = (f32x4){0.f, 0.f, 0.f, 0.f}, cw[4] = {cb, cb, cb, cb};
    for (int unit = blockIdx.x; unit < nb * nchunks * 8; unit += G) {
        const int g = unit & 7, bc = unit >> 3, c = bc % nchunks, b = bc / nchunks;
        const int col = (qi < 32) ? 4096 + g * 128 + 4 * qi : 5120 + g * 128 + 4 * (qi - 32);
        const int ocol = (qi < 32) ? g * 128 + 4 * qi : 1024 + g * 128 + 4 * (qi - 32);
        if (g != cached_g) { cached_g = g; cb = *(const f32x4*)(conv_b + col);
#pragma unroll
            for (int k = 0; k < 4; ++k) cw[k] = *(const f32x4*)(conv_w + k * CONVD + col); }
        u32x2 raw[11];
#pragma unroll
        for (int i = 0; i < 11; ++i) { const int tl = c * 64 + 8 * run - 3 + i; u32x2 v = (u32x2){0u, 0u};
            if (tl < 0) { if (hist) { const f32x4 f = *(const f32x4*)(hist + (size_t)(b * 3 + 3 + tl) * CONVD + col); v.x = pk2(f.x, f.y); v.y = pk2(f.z, f.w); } }
            else if (tl < L) v = *(const u32x2*)(XBC + (size_t)(b * L + tl) * CONVD + col);
            raw[i] = v; }
        float sv[8][4];
#pragma unroll
        for (int i = 0; i < 8; ++i) {
            const int tl = c * 64 + 8 * run + i; const bool valid = tl < L;
            float v0 = cb.x, v1 = cb.y, v2 = cb.z, v3 = cb.w;
#pragma unroll
            for (int k = 0; k < 4; ++k) { const u32x2 rw = raw[i + k];
                v0 += bflo(rw.x) * cw[k].x; v1 += bfhi(rw.x) * cw[k].y; v2 += bflo(rw.y) * cw[k].z; v3 += bfhi(rw.y) * cw[k].w; }
            sv[i][0] = valid ? v0 * sigm(v0) : 0.f; sv[i][1] = valid ? v1 * sigm(v1) : 0.f; sv[i][2] = valid ? v2 * sigm(v2) : 0.f; sv[i][3] = valid ? v3 * sigm(v3) : 0.f;
            if (valid) { u32x2 o; o.x = pk2(sv[i][0], sv[i][1]); o.y = pk2(sv[i][2], sv[i][3]); *(u32x2*)(XCBC + (size_t)(b * L + tl) * 2048 + ocol) = o; }
        }
    }
}

__device__ __forceinline__ void ssd_phase(LAS unsigned char* lds, const bf16_t* XBC, const bf16_t* XCBC, const bf16_t* XBT, const float* DT, const bf16_t* Zs, bf16_t* Y,
                                          const float* hist, const float* h0, float* hout, const float* conv_w, const float* conv_b, const float* a_log, const float* d_skip,
                                          int nb, int L, int G) {
    int tid_l = threadIdx.x; asm volatile("" : "+v"(tid_l));
    const int tid = tid_l, wave = __builtin_amdgcn_readfirstlane(tid >> 6), lane = tid & 63, l15 = lane & 15, quad = lane >> 4;
    LAS float* xs_nat = (LAS float*)(lds);
    LAS bf16_t* xdtT = (LAS bf16_t*)(lds + 17408);
    LAS bf16_t* xtlT = (LAS bf16_t*)(lds + 26624);
    LAS bf16_t* Bnat = (LAS bf16_t*)(lds + 35840);
    LAS bf16_t* BT = (LAS bf16_t*)(lds + 53248);
    LAS bf16_t* Cnat = (LAS bf16_t*)(lds + 71680);
    LAS bf16_t* Ml = (LAS bf16_t*)(lds + 89088);
    LAS bf16_t* Hl = (LAS bf16_t*)(lds + 98304);
    LAS float* scal = (LAS float*)(lds + 115712);
    const int nchunks = (L + 63) >> 6;
    const int qi = tid & 15, rp = tid >> 4;
    const int tt = wave >> 1, wlo = wave & 1;
    int stepctr = 0;
    for (int unit0 = blockIdx.x; unit0 < nb * 64; unit0 += G) {
        int unit = unit0;
        if (G == 256) { const int x = unit0 & 255, slot = x >> 3; unit = (unit0 & ~255) + ((((x & 7) << 2) + (slot >> 3)) << 3) + (slot & 7); }
        const int b = unit >> 6, h = unit & 63, g = h >> 3;
        const float aneg = -__expf(a_log[h]), Dh = d_skip[h];
        const int col = h * 64 + 4 * qi;
        const f32x4 cb = *(const f32x4*)(conv_b + col);
        f32x4 cw[4];
#pragma unroll
        for (int k = 0; k < 4; ++k) cw[k] = *(const f32x4*)(conv_w + k * CONVD + col);
        f32x4 hacc[4];
#pragma unroll
        for (int i = 0; i < 4; ++i) {
            if (h0) hacc[i] = *(const f32x4*)(h0 + ((size_t)(b * 64 + h) * 64 + 16 * tt + l15) * 128 + 16 * (wlo * 4 + i) + 4 * quad);
            else hacc[i] = (f32x4){0.f, 0.f, 0.f, 0.f};
        }
        u32x2 raw[5]; u32x4 bq[2], cq[2]; float dtn = 0.f;
#define SSD_LOAD(cc) do { \
            _Pragma("unroll") for (int i = 0; i < 5; ++i) { const int tl = (cc) * 64 + 2 * rp - 3 + i; u32x2 v = (u32x2){0u, 0u}; \
                if (tl < 0) { if (hist) { const f32x4 f = *(const f32x4*)(hist + (size_t)(b * 3 + 3 + tl) * CONVD + col); v.x = pk2(f.x, f.y); v.y = pk2(f.z, f.w); } } \
                else if (tl < L) v = *(const u32x2*)(XBC + (size_t)(b * L + tl) * CONVD + col); \
                raw[i] = v; } \
            _Pragma("unroll") for (int j = 0; j < 2; ++j) { const int ch = tid + 512 * j, s = ch >> 4, c8 = (ch & 15) * 8, tl = (cc) * 64 + s; \
                bq[j] = (u32x4){0u, 0u, 0u, 0u}; cq[j] = (u32x4){0u, 0u, 0u, 0u}; \
                if (tl < L) { const bf16_t* src = XCBC + (size_t)(b * L + tl) * 2048 + g * 128 + c8; bq[j] = *(const u32x4*)src; cq[j] = *(const u32x4*)(src + 1024); } } \
            if (wave == 0) { const int tl = (cc) * 64 + lane; dtn = (tl < L) ? DT[(size_t)(b * L + tl) * 64 + h] : 0.f; } \
        } while (0)
        SSD_LOAD(0);
        for (int c = 0; c < nchunks; ++c) {
            LAS float* sc = scal + (stepctr & 1) * 320;
            if (wave == 0) {
                const float dtv = dtn; float cum = dtv * aneg;
#pragma unroll
                for (int o = 1; o < 64; o <<= 1) { const float v = __shfl_up(cum, o); if (lane >= o) cum += v; }
                const float cumL = __shfl(cum, 63);
                sc[lane] = dtv; sc[64 + lane] = cum; sc[128 + lane] = __expf(cum); sc[192 + lane] = dtv * __expf(cumL - cum);
                if (lane == 0) sc[256] = __expf(cumL);
            }
            u32x2 zr[2];
            { const int tl = c * 64 + 16 * tt + l15;
#pragma unroll
              for (int pi = 0; pi < 2; ++pi) zr[pi] = (tl < L) ? *(const u32x2*)(Zs + (size_t)(b * L + tl) * DSSM + h * 64 + 16 * (wlo * 2 + pi) + 4 * quad) : (u32x2){0u, 0u}; }
            __syncthreads();
            {
                float sv[2][4];
#pragma unroll
                for (int e = 0; e < 2; ++e) {
                    const bool valid = (c * 64 + 2 * rp + e) < L;
                    float v0 = cb.x, v1 = cb.y, v2 = cb.z, v3 = cb.w;
#pragma unroll
                    for (int k = 0; k < 4; ++k) { const u32x2 rw = raw[e + k];
                        v0 += bflo(rw.x) * cw[k].x; v1 += bfhi(rw.x) * cw[k].y; v2 += bflo(rw.y) * cw[k].z; v3 += bfhi(rw.y) * cw[k].w; }
                    sv[e][0] = valid ? v0 * sigm(v0) : 0.f; sv[e][1] = valid ? v1 * sigm(v1) : 0.f; sv[e][2] = valid ? v2 * sigm(v2) : 0.f; sv[e][3] = valid ? v3 * sigm(v3) : 0.f;
                }
                const int t = 2 * rp;
                *(LAS f32x4*)(xs_nat + t * 68 + 4 * qi) = (f32x4){sv[0][0], sv[0][1], sv[0][2], sv[0][3]};
                *(LAS f32x4*)(xs_nat + (t + 1) * 68 + 4 * qi) = (f32x4){sv[1][0], sv[1][1], sv[1][2], sv[1][3]};
                const float d0 = sc[t], d1 = sc[t + 1], e0 = sc[192 + t], e1 = sc[192 + t + 1];
                const int tsw = ((((t >> 3) ^ (qi & 7)) << 3) + (t & 7));
#pragma unroll
                for (int k = 0; k < 4; ++k) { *(LAS unsigned*)(xdtT + (4 * qi + k) * 72 + tsw) = pk2(sv[0][k] * d0, sv[1][k] * d1);
                    *(LAS unsigned*)(xtlT + (4 * qi + k) * 72 + tsw) = pk2(sv[0][k] * e0, sv[1][k] * e1); }
#pragma unroll
                for (int j = 0; j < 2; ++j) { const int ch = tid + 512 * j;
                    *(LAS u32x4*)(Bnat + (ch >> 4) * 136 + (ch & 15) * 8) = bq[j]; *(LAS u32x4*)(Cnat + (ch >> 4) * 136 + (ch & 15) * 8) = cq[j]; }
            }
            if (c + 1 < nchunks) SSD_LOAD(c + 1);
            __syncthreads();
            bf16x8 Cfr[4];
#pragma unroll
            for (int kn = 0; kn < 4; ++kn) Cfr[kn] = *(const LAS bf16x8*)(Cnat + (16 * tt + l15) * 136 + 32 * kn + 8 * quad);
            { const int t = 16 * tt + l15; const float ct = sc[64 + t];
#pragma unroll
              for (int si = 0; si < 2; ++si) { const int st = wlo * 2 + si;
                f32x4 acc = (f32x4){0.f, 0.f, 0.f, 0.f};
#pragma unroll
                for (int kn = 0; kn < 4; ++kn) { const bf16x8 bfr = *(const LAS bf16x8*)(Bnat + (16 * st + l15) * 136 + 32 * kn + 8 * quad);
                    acc = __builtin_amdgcn_mfma_f32_16x16x32_bf16(bfr, Cfr[kn], acc, 0, 0, 0); }
                const int s0 = 16 * st + 4 * quad; const f32x4 cs = *(const LAS f32x4*)(sc + 64 + s0);
                float m[4];
#pragma unroll
                for (int jj = 0; jj < 4; ++jj) m[jj] = (s0 + jj <= t) ? acc[jj] * __expf(ct - cs[jj]) : 0.f;
                u32x2 o; o.x = pk2(m[0], m[1]); o.y = pk2(m[2], m[3]);
                *(LAS u32x2*)(Ml + t * 72 + s0) = o; }
            }
#pragma unroll
            for (int i = 0; i < 4; ++i) { u32x2 o; o.x = pk2(hacc[i][0], hacc[i][1]); o.y = pk2(hacc[i][2], hacc[i][3]);
                *(LAS u32x2*)(Hl + (16 * tt + l15) * 136 + 16 * (wlo * 4 + i) + 4 * quad) = o; }
            __syncthreads();
            { const int t = 16 * tt + l15, tl = c * 64 + t; const float ec = sc[128 + t];
#pragma unroll
              for (int pi = 0; pi < 2; ++pi) { const int pp = wlo * 2 + pi;
                f32x4 acc = (f32x4){0.f, 0.f, 0.f, 0.f};
#pragma unroll
                for (int kn = 0; kn < 4; ++kn) { const bf16x8 hfr = *(const LAS bf16x8*)(Hl + (16 * pp + l15) * 136 + 32 * kn + 8 * quad);
                    acc = __builtin_amdgcn_mfma_f32_16x16x32_bf16(hfr, Cfr[kn], acc, 0, 0, 0); }
                acc = acc * ec;
#pragma unroll
                for (int ks = 0; ks < 2; ++ks) {
                    if (ks == 0 || tt >= 2) {
                        const bf16x8 xfr = *(const LAS bf16x8*)(xdtT + (16 * pp + l15) * 72 + (((4 * ks + quad) ^ (((16 * pp + l15) >> 2) & 7)) << 3));
                        const bf16x8 mfr = *(const LAS bf16x8*)(Ml + (16 * tt + l15) * 72 + 32 * ks + 8 * quad);
                        acc = __builtin_amdgcn_mfma_f32_16x16x32_bf16(xfr, mfr, acc, 0, 0, 0);
                    }
                }
                const int p0 = 16 * pp + 4 * quad;
                const f32x4 xs = *(const LAS f32x4*)(xs_nat + t * 68 + p0);
                const u32x2 zw = zr[pi];
                u32x2 o; o.x = pk2((acc[0] + Dh * xs[0]) * bflo(zw.x), (acc[1] + Dh * xs[1]) * bfhi(zw.x)); o.y = pk2((acc[2] + Dh * xs[2]) * bflo(zw.y), (acc[3] + Dh * xs[3]) * bfhi(zw.y));
                if (tl < L) *(u32x2*)(Y + (size_t)(b * L + tl) * DSSM + h * 64 + p0) = o; }
            }
            const float eL = sc[256];
            typedef unsigned short u16x4t __attribute__((ext_vector_type(4)));
            u16x4t tr[4][2][2];
            { const unsigned tb = (unsigned)(unsigned long)Bnat + (unsigned)((8 * quad + (l15 >> 2)) * 272 + (64 * wlo + 4 * (lane & 3)) * 2);
              asm volatile(
                "ds_read_b64_tr_b16 %0, %16 offset:0\n\t"    "ds_read_b64_tr_b16 %1, %16 offset:1088\n\t"
                "ds_read_b64_tr_b16 %2, %16 offset:8704\n\t" "ds_read_b64_tr_b16 %3, %16 offset:9792\n\t"
                "ds_read_b64_tr_b16 %4, %16 offset:32\n\t"   "ds_read_b64_tr_b16 %5, %16 offset:1120\n\t"
                "ds_read_b64_tr_b16 %6, %16 offset:8736\n\t" "ds_read_b64_tr_b16 %7, %16 offset:9824\n\t"
                "ds_read_b64_tr_b16 %8, %16 offset:64\n\t"   "ds_read_b64_tr_b16 %9, %16 offset:1152\n\t"
                "ds_read_b64_tr_b16 %10, %16 offset:8768\n\t" "ds_read_b64_tr_b16 %11, %16 offset:9856\n\t"
                "ds_read_b64_tr_b16 %12, %16 offset:96\n\t"  "ds_read_b64_tr_b16 %13, %16 offset:1184\n\t"
                "ds_read_b64_tr_b16 %14, %16 offset:8800\n\t" "ds_read_b64_tr_b16 %15, %16 offset:9888\n\t"
                "s_waitcnt lgkmcnt(0)"
                : "=&v"(tr[0][0][0]), "=&v"(tr[0][0][1]), "=&v"(tr[0][1][0]), "=&v"(tr[0][1][1]),
                  "=&v"(tr[1][0][0]), "=&v"(tr[1][0][1]), "=&v"(tr[1][1][0]), "=&v"(tr[1][1][1]),
                  "=&v"(tr[2][0][0]), "=&v"(tr[2][0][1]), "=&v"(tr[2][1][0]), "=&v"(tr[2][1][1]),
                  "=&v"(tr[3][0][0]), "=&v"(tr[3][0][1]), "=&v"(tr[3][1][0]), "=&v"(tr[3][1][1])
                : "v"(tb) : "memory"); }
#pragma unroll
            for (int i = 0; i < 4; ++i) {
                f32x4 acc = hacc[i] * eL;
#pragma unroll
                for (int ks = 0; ks < 2; ++ks) {
                    bf16x8 btf;
                    btf[0] = (short)tr[i][ks][0][0]; btf[1] = (short)tr[i][ks][0][1]; btf[2] = (short)tr[i][ks][0][2]; btf[3] = (short)tr[i][ks][0][3];
                    btf[4] = (short)tr[i][ks][1][0]; btf[5] = (short)tr[i][ks][1][1]; btf[6] = (short)tr[i][ks][1][2]; btf[7] = (short)tr[i][ks][1][3];
                    const bf16x8 xtf = *(const LAS bf16x8*)(xtlT + (16 * tt + l15) * 72 + (((4 * ks + quad) ^ (((16 * tt + l15) >> 2) & 7)) << 3));
                    acc = __builtin_amdgcn_mfma_f32_16x16x32_bf16(btf, xtf, acc, 0, 0, 0);
                }
                hacc[i] = acc; }
            ++stepctr;
        }
#undef SSD_LOAD
#pragma unroll
        for (int i = 0; i < 4; ++i) *(f32x4*)(hout + ((size_t)(b * 64 + h) * 64 + 16 * tt + l15) * 128 + 16 * (wlo * 4 + i) + 4 * quad) = hacc[i];
    }
    __syncthreads();
}

#ifndef PH_MASK
#define PH_MASK 0xFFFF
#endif
#define PH(k) if ((PH_MASK >> (k)) & 1)
#ifndef PROBE
#define PROBE 0
#endif
#define GBAR() do { gbar(barctr, bartgt, (unsigned)G); if ((PROBE >> 21) & 1) gbar(barctr, bartgt, (unsigned)G); } while (0)
#define PRB(bit) for (int prb_ = 0; prb_ < (((PROBE >> (bit)) & 1) ? 2 : 1); ++prb_)
struct Args { const float* in[24]; float* out; unsigned char* ws; };

__global__ void __launch_bounds__(512, 2) fwd_kernel(Args a) {
    extern __shared__ __attribute__((aligned(16))) unsigned char lds_raw[];
    LAS unsigned char* lds = (LAS unsigned char*)lds_raw;
    cg::grid_group grid = cg::this_grid();
    const int G = gridDim.x, tid = threadIdx.x, wave = __builtin_amdgcn_readfirstlane(tid >> 6), lane = tid & 63;
    const int gw = blockIdx.x * 8 + wave, NGW = G * 8;
    unsigned char* ws = a.ws;
    bf16_t* WIN = (bf16_t*)(ws + WS_WIN); bf16_t* WA = (bf16_t*)(ws + WS_WA); bf16_t* WB = (bf16_t*)(ws + WS_WB); bf16_t* WO = (bf16_t*)(ws + WS_WO);
    bf16_t* WUP = (bf16_t*)(ws + WS_WUP); bf16_t* WDN = (bf16_t*)(ws + WS_WDN);
    bf16_t* HB = (bf16_t*)(ws + WS_H); bf16_t* UB = (bf16_t*)(ws + WS_U); bf16_t* VB = (bf16_t*)(ws + WS_V); bf16_t* ZB = (bf16_t*)(ws + WS_Z);
    bf16_t* XB = (bf16_t*)(ws + WS_XBC); bf16_t* GB = (bf16_t*)(ws + WS_G); bf16_t* YB = (bf16_t*)(ws + WS_Y); float* DTB = (float*)(ws + WS_DT);
    float* TAILB = (float*)(ws + WS_TAIL); bf16_t* MGB = (bf16_t*)(ws + WS_MG); bf16_t* ACTB = (bf16_t*)(ws + WS_ACT);
    bf16_t* XCBC = (bf16_t*)(ws + WS_H); bf16_t* XBT = (bf16_t*)(ws + WS_XBT); float* SSQ = (float*)(ws + WS_SSQ);
    unsigned* barctr = (unsigned*)(ws + WS_BAR); unsigned bartgt = 0;
    float* VST = (float*)(ws + WS_VST);

    {
        LAS bf16_t* scr = (LAS bf16_t*)(lds + wave * 8448);
        constexpr int I_IN = 32 * 289, I_A = 32 * 32, I_B = 64 * 32, I_O = 32 * 32, I_G = 32 * 88, I_U = 32 * 88, I_D = 88 * 32;
        constexpr int NITEMS = I_IN + I_A + I_B + I_O + I_G + I_U + I_D;
        for (int it = gw; it < NITEMS; it += NGW) {
            int r = it;
            if (r < I_IN) { transpose_item(a.in[5], 2048, 18496, WIN, scr, r, lane, 1, nullptr); continue; } r -= I_IN;
            if (r < I_A) { transpose_item(a.in[10], 2048, 2048, WA, scr, r, lane, 0, nullptr); continue; } r -= I_A;
            if (r < I_B) { transpose_item(a.in[17], 4096, 2048, WB, scr, r, lane, 0, a.in[16]); continue; } r -= I_B;
            if (r < I_O) { transpose_item(a.in[18], 2048, 2048, WO, scr, r, lane, 0, nullptr); continue; } r -= I_O;
            if (r < I_G) { transpose_item(a.in[20], 2048, 5632, WUP, scr, r, lane, 2, a.in[19]); continue; } r -= I_G;
            if (r < I_U) { transpose_item(a.in[21], 2048, 5632, WUP, scr, r, lane, 3, a.in[19]); continue; } r -= I_U;
            transpose_item(a.in[22], 5632, 2048, WDN, scr, r, lane, 0, nullptr);
        }
        u32x4* zp = (u32x4*)(WIN + (size_t)18496 * 2048);
        for (int i = blockIdx.x * 512 + tid; i < 192 * 2048 / 8; i += G * 512) zp[i] = (u32x4){0u, 0u, 0u, 0u};
    }

    unsigned char* sws = ws + WS_SMP;
    for (int s = 0; s < 2; ++s) {
        const int nsub = s + 1;
#define SUB_PARAMS(j) \
        const bool smp = ((j) == 1); \
        const int R = smp ? 512 : 16384, nb = smp ? 32 : 4, L = smp ? 16 : 4096; \
        RowMap rm; rm.Ls = smp ? 4 : 12; rm.Lfull = smp ? 16 : 8192; rm.toff = smp ? 0 : s * 4096; \
        const float* xin = smp ? a.in[1] : a.in[0]; \
        float* yout = a.out + (smp ? O_YS : O_YP); \
        const float* hist = smp ? a.in[3] : (s == 1 ? TAILB : nullptr); \
        const float* h0 = smp ? a.in[2] : (s == 1 ? a.out + O_SSMP : nullptr); \
        float* hout = a.out + (smp ? O_SSMS : O_SSMP); \
        float* taildst = smp ? a.out + O_CONVS : (s == 1 ? a.out + O_CONVP : TAILB); \
        bf16_t* bH = smp ? (bf16_t*)(sws + 0 * MiB) : HB;      \
        bf16_t* bU = smp ? (bf16_t*)(sws + 2 * MiB) : UB; \
        bf16_t* bV = smp ? (bf16_t*)(sws + 4 * MiB) : VB; \
        bf16_t* bZ = smp ? (bf16_t*)(sws + 6 * MiB) : ZB; \
        bf16_t* bX = smp ? (bf16_t*)(sws + 10 * MiB) : XB;     \
        bf16_t* bG = smp ? (bf16_t*)(sws + 16 * MiB) : GB; \
        bf16_t* bY = smp ? (bf16_t*)(sws + 20 * MiB) : YB; \
        float* bDT = smp ? (float*)(sws + 24 * MiB) : DTB; \
        bf16_t* bXC = smp ? (bf16_t*)(sws + 25 * MiB) : XCBC; \
        bf16_t* bXT = smp ? (bf16_t*)(sws + 27 * MiB) : XBT; \
        bf16_t* bMG = smp ? (bf16_t*)(sws + 31 * MiB) : MGB; \
        bf16_t* bACT = smp ? (bf16_t*)(sws + 33 * MiB) : ACTB; \
        float* bSSQ = smp ? SSQ + 16384 : SSQ; \
        (void)R; (void)nb; (void)L; (void)rm; (void)xin; (void)yout; (void)hist; (void)h0; (void)hout; (void)taildst; (void)bH; (void)bU; (void)bV; (void)bZ; (void)bX; (void)bG; (void)bY; (void)bDT; (void)bXC; (void)bXT; (void)bMG; (void)bACT; (void)bSSQ;

        for (int j = 0; j < nsub; ++j) { SUB_PARAMS(j) rmsnorm_rows_bf16(xin, rm, a.in[4], bH, R, gw, NGW, lane); }
        for (int i = blockIdx.x * 512 + tid; i < 2 * 16384; i += G * 512) VST[i] = 0.f;
        if (s == 0) { if (blockIdx.x == 0 && tid == 0) __hip_atomic_store(barctr, 0u, __ATOMIC_RELAXED, __HIP_MEMORY_SCOPE_AGENT);
                      grid.sync(); } else GBAR();
        for (int j = 0; j < nsub; ++j) { SUB_PARAMS(j)
          pg8::Gemm g{bH, WIN, R, NIN_PAD, 2048}; pg8::StaticOrder S; S.init(R, NIN_PAD, G, smp ? (int)((blockIdx.x + G - 64) % G) : (int)blockIdx.x);
          EpiInProj E{bU, bV, bZ, bX, bG, bDT, a.in[13], smp ? nullptr : VST};
          pg8::gemm_phase<EpiInProj, pg8::StaticOrder>(lds, g, S, E, nullptr); }
        GBAR();
        for (int j = 0; j < nsub; ++j) { SUB_PARAMS(j)
          if (smp) ln_rows(bV, a.in[6], a.in[7], a.out + O_VS, R, gw, NGW, lane);
          for (int i = blockIdx.x * 512 + tid; i < nb * 3 * CONVD; i += G * 512) { const int bb = i / (3 * CONVD), rem = i % (3 * CONVD), rr = rem / CONVD, cc = rem % CONVD;
              taildst[i] = bf2f(bX[(size_t)(bb * L + L - 3 + rr) * CONVD + cc]); }
          for (int i = blockIdx.x * 512 + tid; i < R; i += G * 512) { bSSQ[i] = 0.f; bSSQ[32768 + i] = 0.f; }
          bcconv_phase(lds, bX, bXC, bXT, hist, a.in[11], a.in[12], nb, L, G); }
        GBAR();
        for (int j = 0; j < nsub; ++j) { SUB_PARAMS(j) sgu_phase(lds, bU, bV, bU, a.in[8], a.in[9], smp ? 32 : 128, smp ? 16 : 128, G, smp ? nullptr : VST, a.in[6], a.in[7]); }
        for (int j = 0; j < nsub; ++j) { SUB_PARAMS(j) ssd_phase(lds, bX, bXC, bXT, bDT, bZ, bY, hist, h0, hout, a.in[11], a.in[12], a.in[14], a.in[15], nb, L, G); }
        GBAR();
        for (int st = 0; st < 2; ++st) {
          const bool normNow = ((st == 0) == (((blockIdx.x >> 3) & 1) == 0));
          if (normNow) { for (int j = 0; j < nsub; ++j) { SUB_PARAMS(j) gnorm_rows(bY, R, gw, NGW, lane); } }
          else { for (int j = 0; j < nsub; ++j) { SUB_PARAMS(j)
            pg8::Gemm g{bU, WA, R, 2048, 2048}; pg8::StaticOrder S; S.init(R, 2048, G, (int)blockIdx.x);
            EpiGate<false> E{bMG, bG, 0};
            pg8::gemm_phase<EpiGate<false>, pg8::StaticOrder>(lds, g, S, E, nullptr); } }
        }
        GBAR();
        for (int j = 0; j < nsub; ++j) { SUB_PARAMS(j)
          pg8::Gemm g{bY, WB, R, 2048, 4096}; pg8::StaticOrder S; S.init(R, 2048, G, (int)blockIdx.x);
          EpiGate<true> E{bMG, bG, 2048};
          pg8::gemm_phase<EpiGate<true>, pg8::StaticOrder>(lds, g, S, E, nullptr); }
        GBAR();
        for (int j = 0; j < nsub; ++j) { SUB_PARAMS(j)
          pg8::Gemm g{bMG, WO, R, 2048, 2048}; pg8::StaticOrder S; S.init(R, 2048, G, (int)blockIdx.x);
          EpiResidNorm E{xin, rm, bH, bSSQ};
          pg8::gemm_phase<EpiResidNorm, pg8::StaticOrder>(lds, g, S, E, nullptr); }
        GBAR();
        for (int j = 0; j < nsub; ++j) { SUB_PARAMS(j)
          pg8::Gemm g{bH, WUP, R, 2 * DFF, 2048}; pg8::StaticOrder S; S.init(R, 2 * DFF, G, (int)blockIdx.x);
          EpiSwiGLU E{bACT, bSSQ};
          pg8::gemm_phase<EpiSwiGLU, pg8::StaticOrder>(lds, g, S, E, nullptr); }
        GBAR();
        for (int j = 0; j < nsub; ++j) { SUB_PARAMS(j)
          pg8::Gemm g{bACT, WDN, R, 2048, DFF}; pg8::StaticOrder S; S.init(R, 2048, G, (int)blockIdx.x);
          EpiResidBf E{bH, bU, bSSQ + 32768};
          pg8::gemm_phase<EpiResidBf, pg8::StaticOrder>(lds, g, S, E, nullptr); }
        GBAR();
        for (int j = 0; j < nsub; ++j) { SUB_PARAMS(j) final_rows(bU, bSSQ + 32768, yout, rm, a.in[23], R, gw, NGW, lane); }
#undef SUB_PARAMS
    }
}

extern "C" void kernel_launch(void* const* d_in, const int* in_sizes, int n_in, void* d_out, int out_size, void* d_ws, size_t ws_size, hipStream_t stream) {
    static int grid_blocks = 0;
    if (!grid_blocks) {
        int dev = 0, cus = 0, per_cu = 0;
        hipGetDevice(&dev);
        hipDeviceGetAttribute(&cus, hipDeviceAttributeMultiprocessorCount, dev);
        hipFuncSetAttribute((const void*)fwd_kernel, hipFuncAttributeMaxDynamicSharedMemorySize, LDS_BYTES);
        hipOccupancyMaxActiveBlocksPerMultiprocessor(&per_cu, (const void*)fwd_kernel, 512, LDS_BYTES);
        if (per_cu < 1) per_cu = 1;
        grid_blocks = cus * per_cu;
        if (ws_size < WS_END || n_in != 24) fprintf(stderr, "kernel_launch: unexpected ws_size %zu (need %zu) or n_in %d\n", ws_size, (size_t)WS_END, n_in);
    }
    Args a{};
    for (int i = 0; i < 24; ++i) a.in[i] = (const float*)d_in[i];
    a.out = (float*)d_out; a.ws = (unsigned char*)d_ws;
    void* args[] = {&a};
    hipError_t e = hipLaunchCooperativeKernel((const void*)fwd_kernel, dim3(grid_blocks), dim3(512), args, LDS_BYTES, stream);
    if (e != hipSuccess) fprintf(stderr, "cooperative launch failed: %s (grid %d)\n", hipGetErrorString(e), grid_blocks);
}
```
